# Optimizing an MI355X kernel written in HIP

```python
import math
import jax, jax.numpy as jnp
from jax import lax
import numpy as np

D_MODEL = 1024
BATCH = 4
SEQ = 4096
DEPTH = 1

GDN_HEADS = 4
GDN_HEAD_DIM = 128
MLSTM_HEADS = 4
MLSTM_HEAD_DIM = 128
GDN_W = GDN_HEADS * GDN_HEAD_DIM
MLSTM_W = MLSTM_HEADS * MLSTM_HEAD_DIM
CONV_WIDTH = 4
GDN_CHUNK = 64
MLSTM_CHUNK = 64
PROJ_SIZES = (3 * GDN_W, GDN_W, GDN_HEADS, GDN_HEADS,
              2 * MLSTM_W, MLSTM_W, MLSTM_W, MLSTM_HEADS, MLSTM_HEADS)
PROJ_DIM = sum(PROJ_SIZES)
MEM_TOKENS = 256
XA_HEADS = 4
XA_HEAD_DIM = D_MODEL // XA_HEADS
PEER_HEADS = 8
PEER_N_KEYS = 128
PEER_N_EXPERTS = PEER_N_KEYS * PEER_N_KEYS
PEER_TOPK = 16
PEER_HALF = 128
PEER_QUERY_DIM = 2 * PEER_HALF
PEER_BLOCK = 128
NORM_EPS = 1e-6

kernel_name = 'hymba_gdn_mlstm_peer_block'


def rmsnorm(x, w):
    xf = x.astype(jnp.float32)
    y = xf * lax.rsqrt(jnp.mean(xf * xf, axis=-1, keepdims=True) + NORM_EPS)
    return (y * w.astype(jnp.float32)).astype(x.dtype)


def l2norm(x):
    return x * lax.rsqrt(jnp.sum(x * x, axis=-1, keepdims=True) + NORM_EPS)


def causal_dwconv(x, w):
    kw = w.shape[0]
    return lax.conv_general_dilated(x, w[:, None, :].astype(x.dtype), window_strides=(1,),
                                    padding=[(kw - 1, 0)],
                                    dimension_numbers=('NWC', 'WIO', 'NWC'),
                                    feature_group_count=x.shape[-1])


def to_chunks(t, nc, lc):
    b, h = t.shape[0], t.shape[1]
    return jnp.moveaxis(t.reshape(b, h, nc, lc, *t.shape[3:]), 2, 0)


def gated_delta_rule(q, k, v, log_alpha, beta):
    b, nh, s, dk = q.shape
    dv = v.shape[-1]
    lc = GDN_CHUNK
    nc = s // lc
    q = q * dk ** -0.5
    q, k, v, log_alpha, beta = (to_chunks(t, nc, lc) for t in (q, k, v, log_alpha, beta))
    gc = jnp.cumsum(log_alpha, axis=-1)
    idx = jnp.arange(lc)
    causal = idx[:, None] >= idx[None, :]
    strict = idx[:, None] > idx[None, :]
    decay = jnp.exp(jnp.where(causal, gc[..., :, None] - gc[..., None, :], -jnp.inf))
    kb = k * beta[..., None]
    a = jnp.where(strict, jnp.einsum('nbhid,nbhjd->nbhij', kb, k) * decay, 0.0)
    eye = jnp.eye(lc, dtype=q.dtype)
    t_inv = lax.linalg.triangular_solve(a + eye, jnp.broadcast_to(eye, a.shape), left_side=True,
                                        lower=True, unit_diagonal=True)
    u = t_inv @ (v * beta[..., None])
    w = t_inv @ (kb * jnp.exp(gc)[..., None])
    qk = jnp.einsum('nbhid,nbhjd->nbhij', q, k) * decay
    q_dec = q * jnp.exp(gc)[..., None]
    k_dec = k * jnp.exp(gc[..., -1:] - gc)[..., None]
    g_last = jnp.exp(gc[..., -1])

    def step(state, xs):
        u_c, w_c, qk_c, qd_c, kd_c, gl_c = xs
        v_new = u_c - w_c @ state
        o = qd_c @ state + qk_c @ v_new
        state = state * gl_c[..., None, None] + jnp.einsum('bhld,bhle->bhde', kd_c, v_new)
        return state, o

    s0 = jnp.zeros((b, nh, dk, dv), q.dtype)
    _, o = lax.scan(step, s0, (u, w, qk, q_dec, k_dec, g_last))
    return jnp.moveaxis(o, 0, 2).reshape(b, nh, s, dv)


def mlstm_chunkwise(q, k, v, log_i, log_f):
    b, nh, s, dk = q.shape
    dv = v.shape[-1]
    lc = MLSTM_CHUNK
    nc = s // lc
    k = k * dk ** -0.5
    q, k, v, log_i, log_f = (to_chunks(t, nc, lc) for t in (q, k, v, log_i, log_f))
    bcum = jnp.cumsum(log_f, axis=-1)
    idx = jnp.arange(lc)
    causal = idx[:, None] >= idx[None, :]
    d_intra = jnp.where(causal, bcum[..., :, None] - bcum[..., None, :] + log_i[..., None, :], -jnp.inf)
    d_last = bcum[..., -1:] - bcum + log_i
    qk = jnp.einsum('nbhid,nbhjd->nbhij', q, k)

    def step(carry, xs):
        c, n, m = carry
        q_c, k_c, v_c, b_c, d_c, qk_c, dl_c = xs
        inter = b_c + m[..., None]
        m_t = jnp.maximum(inter, jnp.max(d_c, axis=-1))
        p = qk_c * jnp.exp(d_c - m_t[..., None])
        sc = jnp.exp(inter - m_t)
        num = sc[..., None] * (q_c @ c) + p @ v_c
        den = sc * jnp.einsum('bhld,bhd->bhl', q_c, n) + jnp.sum(p, axis=-1)
        h = num / jnp.maximum(jnp.abs(den), jnp.exp(-m_t))[..., None]
        b_last = b_c[..., -1]
        m_new = jnp.maximum(b_last + m, jnp.max(dl_c, axis=-1))
        wgt = jnp.exp(dl_c - m_new[..., None])
        dec = jnp.exp(b_last + m - m_new)
        c = dec[..., None, None] * c + jnp.einsum('bhld,bhle->bhde', k_c * wgt[..., None], v_c)
        n = dec[..., None] * n + jnp.einsum('bhld,bhl->bhd', k_c, wgt)
        return (c, n, m_new), h

    init = (jnp.zeros((b, nh, dk, dv), q.dtype), jnp.zeros((b, nh, dk), q.dtype),
            jnp.zeros((b, nh), q.dtype))
    _, hs = lax.scan(step, init, (q, k, v, bcum, d_intra, qk, d_last))
    return jnp.moveaxis(hs, 0, 2).reshape(b, nh, s, dv)


def hybrid_mixer(h, w_in, gdn_conv_w, gdn_a_log, gdn_dt_bias, gdn_norm_w,
                 mlstm_conv_w, mlstm_i_bias, mlstm_f_bias, mlstm_norm_w, w_out):
    b, s, _ = h.shape
    f32 = jnp.float32
    proj = (h @ w_in).astype(f32)
    cuts = np.cumsum(PROJ_SIZES)[:-1].tolist()
    g_qkv, g_z, g_a, g_b, m_qk, m_v, m_o, m_i, m_f = jnp.split(proj, cuts, axis=-1)

    def heads(t, nh):
        return t.reshape(b, s, nh, -1).transpose(0, 2, 1, 3)

    g_qkv = jax.nn.silu(causal_dwconv(g_qkv, gdn_conv_w.astype(f32)))
    gq, gk, gv = (heads(t, GDN_HEADS) for t in jnp.split(g_qkv, 3, axis=-1))
    gq, gk = l2norm(gq), l2norm(gk)
    log_alpha = -jnp.exp(gdn_a_log.astype(f32)) * jax.nn.softplus(g_a + gdn_dt_bias.astype(f32))
    beta = jax.nn.sigmoid(g_b)
    go = gated_delta_rule(gq, gk, gv, log_alpha.transpose(0, 2, 1), beta.transpose(0, 2, 1))
    go = rmsnorm(go.transpose(0, 2, 1, 3), gdn_norm_w) * jax.nn.silu(
        g_z.reshape(b, s, GDN_HEADS, GDN_HEAD_DIM))

    m_qk = jax.nn.silu(causal_dwconv(m_qk, mlstm_conv_w.astype(f32)))
    mq, mk = (heads(t, MLSTM_HEADS) for t in jnp.split(m_qk, 2, axis=-1))
    mv = heads(m_v, MLSTM_HEADS)
    log_i = (m_i + mlstm_i_bias.astype(f32)).transpose(0, 2, 1)
    log_f = jax.nn.log_sigmoid(m_f + mlstm_f_bias.astype(f32)).transpose(0, 2, 1)
    mh = mlstm_chunkwise(mq, mk, mv, log_i, log_f)
    mh = rmsnorm(mh.transpose(0, 2, 1, 3), mlstm_norm_w.reshape(MLSTM_HEADS, MLSTM_HEAD_DIM)) * \
        jax.nn.sigmoid(m_o.reshape(b, s, MLSTM_HEADS, MLSTM_HEAD_DIM))

    mixed = jnp.concatenate([go.reshape(b, s, GDN_W), mh.reshape(b, s, MLSTM_W)], axis=-1)
    return mixed.astype(h.dtype) @ w_out


def memory_cross_attention(h, m, wq, wkv, wo):
    b, s, _ = h.shape
    q = (h @ wq).reshape(b, s, XA_HEADS, XA_HEAD_DIM)
    k, v = jnp.split(m @ wkv, 2, axis=-1)
    k = k.reshape(b, -1, XA_HEADS, XA_HEAD_DIM)
    v = v.reshape(b, -1, XA_HEADS, XA_HEAD_DIM)
    scores = jnp.einsum('bshd,bmhd->bhsm', q, k).astype(jnp.float32) * XA_HEAD_DIM ** -0.5
    p = jax.nn.softmax(scores, axis=-1).astype(v.dtype)
    o = jnp.einsum('bhsm,bmhd->bshd', p, v).reshape(b, s, D_MODEL)
    return o @ wo


def peer_ffn(h, wq, sub_keys, u_table, v_table):
    b, s, d = h.shape
    t = b * s
    hf = h.reshape(t, d)
    q = (hf @ wq).reshape(t, PEER_HEADS, 2, PEER_HALF)
    sc = jnp.einsum('thpd,hpnd->thpn', q, sub_keys).astype(jnp.float32)
    top_v, top_i = lax.top_k(sc, PEER_TOPK)
    kk = PEER_TOPK * PEER_TOPK
    cand = (top_v[:, :, 0, :, None] + top_v[:, :, 1, None, :]).reshape(t, PEER_HEADS, kk)
    cand_id = (top_i[:, :, 0, :, None] * PEER_N_KEYS + top_i[:, :, 1, None, :]).reshape(t, PEER_HEADS, kk)
    best_v, best_pos = lax.top_k(cand, PEER_TOPK)
    expert_id = jnp.take_along_axis(cand_id, best_pos, axis=-1)
    gate = jax.nn.softmax(best_v, axis=-1)
    nb = t // PEER_BLOCK

    def block(args):
        xb, eb, gb = args
        u = jnp.take(u_table, eb, axis=0)
        act = jax.nn.gelu(jnp.einsum('phkd,pd->phk', u, xb).astype(jnp.float32), approximate=False)
        wgt = (gb * act).astype(v_table.dtype)
        return jnp.einsum('phk,phkd->pd', wgt, jnp.take(v_table, eb, axis=0))

    out = lax.map(block, (hf.reshape(nb, PEER_BLOCK, d),
                          expert_id.reshape(nb, PEER_BLOCK, PEER_HEADS, PEER_TOPK),
                          gate.reshape(nb, PEER_BLOCK, PEER_HEADS, PEER_TOPK)))
    return out.reshape(b, s, d).astype(h.dtype)


def setup_inputs(seed: int = 0) -> dict:
    key = jax.random.key(seed)
    ks = jax.random.split(key, 24)
    f32 = jnp.float32
    L, D = DEPTH, D_MODEL

    def nrm(k, shape, scale):
        return jax.random.normal(k, shape, f32) * scale

    def gain(k, shape):
        return 1.0 + 0.01 * jax.random.normal(k, shape, f32)

    dt = jnp.exp(jax.random.uniform(ks[6], (L, GDN_HEADS), f32, math.log(1e-3), math.log(1e-1)))
    return {
        'x': nrm(ks[0], (BATCH, SEQ, D), 1.0),
        'mem': nrm(ks[1], (BATCH, MEM_TOKENS, D), 1.0),
        'norm_mix_w': gain(ks[2], (L, D)),
        'w_in': nrm(ks[3], (L, D, PROJ_DIM), D ** -0.5),
        'gdn_conv_w': nrm(ks[4], (L, CONV_WIDTH, 3 * GDN_W), CONV_WIDTH ** -0.5),
        'gdn_a_log': jnp.log(jax.random.uniform(ks[5], (L, GDN_HEADS), f32, 1.0, 16.0)),
        'gdn_dt_bias': dt + jnp.log(-jnp.expm1(-dt)),
        'gdn_norm_w': gain(ks[7], (L, GDN_HEAD_DIM)),
        'mlstm_conv_w': nrm(ks[8], (L, CONV_WIDTH, 2 * MLSTM_W), CONV_WIDTH ** -0.5),
        'mlstm_i_bias': nrm(ks[9], (L, MLSTM_HEADS), 0.5),
        'mlstm_f_bias': jax.random.uniform(ks[10], (L, MLSTM_HEADS), f32, 3.0, 6.0),
        'mlstm_norm_w': gain(ks[11], (L, MLSTM_W)),
        'w_out': nrm(ks[12], (L, GDN_W + MLSTM_W, D), (GDN_W + MLSTM_W) ** -0.5),
        'norm_xa_w': gain(ks[13], (L, D)),
        'norm_mem_w': gain(ks[14], (L, D)),
        'xa_wq': nrm(ks[15], (L, D, D), D ** -0.5),
        'xa_wkv': nrm(ks[16], (L, D, 2 * D), D ** -0.5),
        'xa_wo': nrm(ks[17], (L, D, D), D ** -0.5),
        'norm_ffn_w': gain(ks[18], (L, D)),
        'peer_wq': nrm(ks[19], (L, D, PEER_HEADS * PEER_QUERY_DIM), D ** -0.5),
        'peer_sub_keys': nrm(ks[20], (L, PEER_HEADS, 2, PEER_N_KEYS, PEER_HALF), PEER_HALF ** -0.5),
        'peer_u': nrm(ks[21], (L, PEER_N_EXPERTS, D), D ** -0.5),
        'peer_v': nrm(ks[22], (L, PEER_N_EXPERTS, D), (PEER_HEADS * PEER_TOPK) ** -0.5),
        'norm_final_w': gain(ks[23], (D,)),
    }


def reference(x, mem, norm_mix_w, w_in, gdn_conv_w, gdn_a_log, gdn_dt_bias, gdn_norm_w,
              mlstm_conv_w, mlstm_i_bias, mlstm_f_bias, mlstm_norm_w, w_out,
              norm_xa_w, norm_mem_w, xa_wq, xa_wkv, xa_wo,
              norm_ffn_w, peer_wq, peer_sub_keys, peer_u, peer_v, norm_final_w):
    for l in range(DEPTH):
        x = x + hybrid_mixer(rmsnorm(x, norm_mix_w[l]), w_in[l], gdn_conv_w[l], gdn_a_log[l],
                             gdn_dt_bias[l], gdn_norm_w[l], mlstm_conv_w[l], mlstm_i_bias[l],
                             mlstm_f_bias[l], mlstm_norm_w[l], w_out[l])
        x = x + memory_cross_attention(rmsnorm(x, norm_xa_w[l]), rmsnorm(mem, norm_mem_w[l]),
                                       xa_wq[l], xa_wkv[l], xa_wo[l])
        x = x + peer_ffn(rmsnorm(x, norm_ffn_w[l]), peer_wq[l], peer_sub_keys[l], peer_u[l], peer_v[l])
    return rmsnorm(x, norm_final_w)
```

```cpp
#include <hip/hip_runtime.h>
#include <hip/hip_cooperative_groups.h>
#include <cstdio>
namespace cg = cooperative_groups;

typedef unsigned short bf16_t;
using bf16x8 = __attribute__((ext_vector_type(8))) short;
using f32x4 = __attribute__((ext_vector_type(4))) float;
using f32x16 = __attribute__((ext_vector_type(16))) float;
using u32x4 = __attribute__((ext_vector_type(4))) unsigned;

#define DI __device__ __forceinline__
#define MFMA32(a, b, c) __builtin_amdgcn_mfma_f32_32x32x16_bf16((a), (b), (c), 0, 0, 0)
#define MFMA16(a, b, c) __builtin_amdgcn_mfma_f32_16x16x32_bf16((a), (b), (c), 0, 0, 0)

static constexpr int T_TOK = 16384;
static constexpr size_t MiB = 1024 * 1024;
static constexpr size_t OFF_P = 0;
static constexpr size_t OFF_R1 = 128 * MiB;
static constexpr size_t OFF_R2 = 200 * MiB;
static constexpr size_t OFF_WINT = OFF_R2;
static constexpr size_t OFF_WOUTT = OFF_WINT + 4224 * 1024 * 2;
static constexpr size_t OFF_WQT = OFF_WOUTT + 2 * MiB;
static constexpr size_t OFF_WKVT = OFF_WQT + 2 * MiB;
static constexpr size_t OFF_WOT = OFF_WKVT + 4 * MiB;
static constexpr size_t OFF_PWQT = OFF_WOT + 2 * MiB;
static constexpr size_t OFF_SKB = OFF_PWQT + 4 * MiB;
static constexpr size_t OFF_G = OFF_SKB + MiB / 2;
static constexpr size_t OFF_MEMN = OFF_G + 1 * MiB;
static constexpr size_t OFF_KB = OFF_MEMN + 2 * MiB;
static constexpr size_t OFF_VT = OFF_KB + 2 * MiB;
static constexpr size_t OFF_GLAST = OFF_VT + 2 * MiB;
static constexpr size_t OFF_MSMALL = OFF_GLAST + 4096;
static constexpr size_t OFF_BAR = OFF_MSMALL + 2 * MiB;
static constexpr size_t OFF_END = OFF_BAR + 16384;
static constexpr size_t OFF_H2 = 0;
static constexpr size_t OFF_QX = 32 * MiB;
static constexpr size_t OFF_AO = 64 * MiB;
static constexpr size_t OFF_H3 = 96 * MiB;
static constexpr size_t OFF_EID = 0;
static constexpr size_t OFF_GATE = 8 * MiB;
static constexpr size_t OFF_PART = 16 * MiB;
static constexpr size_t OFF_W = 80 * MiB;
static constexpr size_t OFF_SSP = 88 * MiB;
static constexpr size_t OFF_MX = OFF_R1;
static constexpr size_t OFF_UB = OFF_R1;
static constexpr size_t OFF_VB = OFF_R1 + 16 * MiB;
static constexpr size_t OFF_USC = OFF_R1 + 64 * MiB;
static constexpr size_t OFF_VSC = OFF_USC + 65536;

static constexpr int GDN_INT_BYTES = 73728;
static constexpr int ML_INT_BYTES = 57344;
static constexpr int SMEM_BYTES = 77824;

struct Params {
  const float *x, *mem, *norm_mix_w, *w_in, *gdn_conv_w, *gdn_a_log, *gdn_dt_bias, *gdn_norm_w, *mlstm_conv_w,
      *mlstm_i_bias, *mlstm_f_bias, *mlstm_norm_w, *w_out, *norm_xa_w, *norm_mem_w, *xa_wq, *xa_wkv, *xa_wo,
      *norm_ffn_w, *peer_wq, *peer_sub_keys, *peer_u, *peer_v, *norm_final_w;
  float* out;
  char* ws;
};

typedef float f32x2 __attribute__((ext_vector_type(2)));
typedef __bf16 bf16x2_t __attribute__((ext_vector_type(2)));
DI unsigned pk2(float a, float b) {
  f32x2 v = {a, b};
  bf16x2_t r = __builtin_convertvector(v, bf16x2_t);
  return __builtin_bit_cast(unsigned, r);
}
DI bf16_t f2bf(float f) { return (bf16_t)(pk2(f, 0.f) & 0xffffu); }
DI float bf2f(bf16_t h) { return __uint_as_float(((unsigned)h) << 16); }
DI float bflo(unsigned u) { return __uint_as_float(u << 16); }
DI float bfhi(unsigned u) { return __uint_as_float(u & 0xffff0000u); }
DI void unpack8(const uint4& v, float* f) {
  f[0] = bflo(v.x); f[1] = bfhi(v.x); f[2] = bflo(v.y); f[3] = bfhi(v.y);
  f[4] = bflo(v.z); f[5] = bfhi(v.z); f[6] = bflo(v.w); f[7] = bfhi(v.w);
}
DI uint4 pack8(const float* f) {
  uint4 v; v.x = pk2(f[0], f[1]); v.y = pk2(f[2], f[3]); v.z = pk2(f[4], f[5]); v.w = pk2(f[6], f[7]);
  return v;
}
DI float wave_sum(float v) {
#pragma unroll
  for (int o = 32; o >= 1; o >>= 1) v += __shfl_xor(v, o);
  return v;
}
DI float sigmoidf_(float x) { return __builtin_amdgcn_rcpf(1.f + __expf(-x)); }
DI float softplusf_(float x) { return fmaxf(x, 0.f) + __logf(1.f + __expf(-fabsf(x))); }
DI float logsigf_(float x) { return fminf(x, 0.f) - __logf(1.f + __expf(-fabsf(x))); }
DI int otid() { int t = threadIdx.x; asm volatile("" : "+v"(t)); return t; }
DI int fragoff(int row, int k, int KS) { return (((row >> 4) * KS + (k >> 5)) << 9) + (((((k >> 3) & 3) << 4) + (row & 15)) << 3) + (k & 7); }
DI int crow32(int r, int half) { return (r & 3) + 8 * (r >> 2) + 4 * half; }


#define XB_TMO      128
#define XB_XCNT(j)  (256  + 64 * (j))
#define XB_XSUB(j)  (1280 + 64 * (j))
#define XB_XGEN(j)  (2304 + 64 * (j))
#define XB_TOP      3328
#define XB_TOPGEN   3392
#define XCD_BAR_WORDS 3456
#define XB_SPIN_CAP (1u << 18)
#define LAS __attribute__((address_space(3)))
DI unsigned xb_ld(unsigned* p) { return __hip_atomic_load(p, __ATOMIC_RELAXED, __HIP_MEMORY_SCOPE_AGENT); }
DI unsigned xb_add(unsigned* p, unsigned v) { return __hip_atomic_fetch_add(p, v, __ATOMIC_RELAXED, __HIP_MEMORY_SCOPE_AGENT); }
DI unsigned xb_xcc_id() { return (unsigned)__builtin_amdgcn_s_getreg((3 << 11) | 20) & 0xFu; }
#define XB_SPIN(cond, bar) do { unsigned _sp = 0; while (cond) { __builtin_amdgcn_s_sleep(1); \
    if ((++_sp & 255u) == 0u) { if (xb_ld(&(bar)[XB_TMO])) break; if (_sp > XB_SPIN_CAP) { atomicAdd(&(bar)[XB_TMO], 1u); break; } } } } while (0)
struct XcdBarrier { unsigned* bar; unsigned x; volatile LAS unsigned* st; };
DI XcdBarrier xcd_barrier_post(unsigned* bar, volatile LAS unsigned* st) {
  XcdBarrier b; b.bar = bar; b.x = xb_xcc_id(); b.st = st;
  if (threadIdx.x == 0) (void)xb_add(&bar[XB_XCNT(b.x)], 1u);
  return b;
}
DI void xcd_barrier_complete(unsigned* bar, unsigned x, unsigned& nloc, unsigned& nx) {
  const unsigned G = gridDim.x * gridDim.y * gridDim.z;
  unsigned sum, cnt, mine, sp = 0u;
  for (;;) {
    sum = 0u; cnt = 0u; mine = 0u;
#pragma unroll
    for (unsigned j = 0; j < 16; ++j) { const unsigned c = xb_ld(&bar[XB_XCNT(j)]); sum += c; cnt += (c > 0u) ? 1u : 0u; mine = (j == x) ? c : mine; }
    if (sum == G) break;
    __builtin_amdgcn_s_sleep(1);
    if ((++sp & 255u) == 0u) { if (xb_ld(&bar[XB_TMO])) break; if (sp > XB_SPIN_CAP) { atomicAdd(&bar[XB_TMO], 1u); break; } }
  }
  nloc = mine > 0u ? mine : 1u; nx = cnt > 0u ? cnt : 1u;
}
DI void xcd_barrier(const XcdBarrier& b) {
  asm volatile("s_waitcnt vmcnt(0)" ::: "memory");
  __syncthreads();
  if (threadIdx.x == 0) {
    unsigned* bar = b.bar;
    __builtin_amdgcn_s_waitcnt(0);
    unsigned nloc = b.st[0], nx = b.st[1];
    if (nloc == 0u) { xcd_barrier_complete(bar, b.x, nloc, nx); b.st[0] = nloc; b.st[1] = nx; }
    const unsigned old = xb_add(&bar[XB_XSUB(b.x)], 1u);
    const unsigned gen = old / nloc;
    if (old + 1u == (gen + 1u) * nloc) {
      __builtin_amdgcn_fence(__ATOMIC_RELEASE, "agent");
      asm volatile("s_waitcnt vmcnt(0)" ::: "memory");
      const unsigned og = xb_add(&bar[XB_TOP], 1u);
      const unsigned tg = og / nx;
      if (og + 1u == (tg + 1u) * nx) xb_add(&bar[XB_TOPGEN], 1u);
      else XB_SPIN(xb_ld(&bar[XB_TOPGEN]) == tg, bar);
      __builtin_amdgcn_fence(__ATOMIC_ACQUIRE, "agent");
      xb_add(&bar[XB_XGEN(b.x)], 1u);
      asm volatile("s_waitcnt vmcnt(0)" ::: "memory");
    } else {
      XB_SPIN(xb_ld(&bar[XB_XGEN(b.x)]) == gen, bar);
      __builtin_amdgcn_fence(__ATOMIC_ACQUIRE, "agent");
      asm volatile("s_waitcnt vmcnt(0)" ::: "memory");
    }
  }
  __syncthreads();
}

DI int winmap(int np) {
  if (np < 2048) return np;
  if (np < 4096) return np + 8;
  int j = np - 4096;
  return j < 8 ? 2048 + j : 4104 + (j - 8);
}
DI void transpose_tile(const float* __restrict__ W, int K, int N, bf16_t* __restrict__ Wt, int Np, int kt, int nt,
                       int mode, float* sm) {
  const int tid = otid();
  const int tx = tid & 63, ty = tid >> 6;
#pragma unroll 4
  for (int i = 0; i < 16; ++i) {
    int k = ty + 4 * i;
    int np = nt * 64 + tx;
    float v = 0.f;
    if (np < Np) {
      int n = mode ? winmap(np) : np;
      v = W[(size_t)(kt * 64 + k) * N + n];
    }
    sm[k * 65 + tx] = v;
  }
  __syncthreads();
#pragma unroll 4
  for (int i = 0; i < 16; ++i) {
    int n = ty + 4 * i;
    int np = nt * 64 + n;
    if (np < Np) Wt[(size_t)np * K + kt * 64 + tx] = f2bf(sm[tx * 65 + n]);
  }
  __syncthreads();
}
DI void transpose_all(const float* W, int K, int N, bf16_t* Wt, int Np, int mode, float* sm) {
  const int ntn = (Np + 63) / 64, ntk = K / 64;
  for (int t = blockIdx.x; t < ntn * ntk; t += gridDim.x) transpose_tile(W, K, N, Wt, Np, t / ntn, t % ntn, mode, sm);
}
DI void rmsnorm_row(const float* __restrict__ src, const float* __restrict__ w, bf16_t* __restrict__ dst, int lane) {
  float4 v[4];
  float ss = 0.f;
#pragma unroll
  for (int j = 0; j < 4; ++j) {
    v[j] = ((const float4*)src)[lane + 64 * j];
    ss += v[j].x * v[j].x + v[j].y * v[j].y + v[j].z * v[j].z + v[j].w * v[j].w;
  }
  ss = wave_sum(ss);
  const float r = rsqrtf(ss * (1.f / 1024.f) + 1e-6f);
#pragma unroll
  for (int j = 0; j < 4; ++j) {
    float4 ww = ((const float4*)w)[lane + 64 * j];
    uint2 o;
    o.x = pk2(v[j].x * r * ww.x, v[j].y * r * ww.y);
    o.y = pk2(v[j].z * r * ww.z, v[j].w * r * ww.w);
    ((uint2*)dst)[lane + 64 * j] = o;
  }
}
DI void rmsnorm_rows(const float* src, const float* w, bf16_t* dst, int nrows) {
  const int tid_ = otid(); const int lane = tid_ & 63, wave = tid_ >> 6;
  for (int r = blockIdx.x * 4 + wave; r < nrows; r += gridDim.x * 4)
    rmsnorm_row(src + (size_t)r * 1024, w, dst + (size_t)r * 1024, lane);
}
DI void convert_f32_bf16(const float* src, bf16_t* dst, size_t n4) {
  for (size_t i = (size_t)blockIdx.x * 256 + threadIdx.x; i < n4; i += (size_t)gridDim.x * 256) {
    float4 v = ((const float4*)src)[i];
    uint2 o; o.x = pk2(v.x, v.y); o.y = pk2(v.z, v.w);
    ((uint2*)dst)[i] = o;
  }
}

static constexpr int LDS_ROW = 72;
template <class Epi>
DI void gemm128(const bf16_t* __restrict__ A, int lda, const bf16_t* __restrict__ B, int ldb, int K, int m0, int n0,
                bf16_t* sA, bf16_t* sB, Epi epi) {
  const int tid = otid(), lane = tid & 63, wave = tid >> 6;
  const int wm = wave >> 1, wn = wave & 1;
  const int lr = tid >> 3, lc = (tid & 7) * 8;
  f32x16 acc[2][2];
#pragma unroll
  for (int i = 0; i < 2; ++i)
#pragma unroll
    for (int j = 0; j < 2; ++j)
#pragma unroll
      for (int r = 0; r < 16; ++r) acc[i][j][r] = 0.f;
  u32x4 ra0, ra1, ra2, ra3, rb0, rb1, rb2, rb3;
  const bf16_t* Ap = A + (size_t)(m0 + lr) * lda + lc;
  const bf16_t* Bp = B + (size_t)(n0 + lr) * ldb + lc;
  ra0 = *(const u32x4*)(Ap); ra1 = *(const u32x4*)(Ap + (size_t)32 * lda);
  ra2 = *(const u32x4*)(Ap + (size_t)64 * lda); ra3 = *(const u32x4*)(Ap + (size_t)96 * lda);
  rb0 = *(const u32x4*)(Bp); rb1 = *(const u32x4*)(Bp + (size_t)32 * ldb);
  rb2 = *(const u32x4*)(Bp + (size_t)64 * ldb); rb3 = *(const u32x4*)(Bp + (size_t)96 * ldb);
  const int nk = K >> 6;
  for (int kt = 0; kt < nk; ++kt) {
    __syncthreads();
    *(u32x4*)(sA + (lr) * LDS_ROW + lc) = ra0; *(u32x4*)(sA + (lr + 32) * LDS_ROW + lc) = ra1;
    *(u32x4*)(sA + (lr + 64) * LDS_ROW + lc) = ra2; *(u32x4*)(sA + (lr + 96) * LDS_ROW + lc) = ra3;
    *(u32x4*)(sB + (lr) * LDS_ROW + lc) = rb0; *(u32x4*)(sB + (lr + 32) * LDS_ROW + lc) = rb1;
    *(u32x4*)(sB + (lr + 64) * LDS_ROW + lc) = rb2; *(u32x4*)(sB + (lr + 96) * LDS_ROW + lc) = rb3;
    __syncthreads();
    if (kt + 1 < nk) {
      const int ko2 = (kt + 1) * 64;
      ra0 = *(const u32x4*)(Ap + ko2); ra1 = *(const u32x4*)(Ap + (size_t)32 * lda + ko2);
      ra2 = *(const u32x4*)(Ap + (size_t)64 * lda + ko2); ra3 = *(const u32x4*)(Ap + (size_t)96 * lda + ko2);
      rb0 = *(const u32x4*)(Bp + ko2); rb1 = *(const u32x4*)(Bp + (size_t)32 * ldb + ko2);
      rb2 = *(const u32x4*)(Bp + (size_t)64 * ldb + ko2); rb3 = *(const u32x4*)(Bp + (size_t)96 * ldb + ko2);
    }
#pragma unroll
    for (int s = 0; s < 4; ++s) {
      const int ko = s * 16 + (lane >> 5) * 8;
      bf16x8 a0 = *(const bf16x8*)(sA + (wm * 64 + (lane & 31)) * LDS_ROW + ko);
      bf16x8 a1 = *(const bf16x8*)(sA + (wm * 64 + 32 + (lane & 31)) * LDS_ROW + ko);
      bf16x8 b0 = *(const bf16x8*)(sB + (wn * 64 + (lane & 31)) * LDS_ROW + ko);
      bf16x8 b1 = *(const bf16x8*)(sB + (wn * 64 + 32 + (lane & 31)) * LDS_ROW + ko);
      acc[0][0] = MFMA32(a0, b0, acc[0][0]);
      acc[0][1] = MFMA32(a0, b1, acc[0][1]);
      acc[1][0] = MFMA32(a1, b0, acc[1][0]);
      acc[1][1] = MFMA32(a1, b1, acc[1][1]);
    }
  }
#pragma unroll
  for (int i = 0; i < 2; ++i)
#pragma unroll
    for (int j = 0; j < 2; ++j)
#pragma unroll
      for (int r = 0; r < 16; ++r) {
        const int m = m0 + wm * 64 + i * 32 + crow32(r, lane >> 5);
        const int n = n0 + wn * 64 + j * 32 + (lane & 31);
        epi(m, n, acc[i][j][r]);
      }
}

template <class Epi>
DI void gemm256(const bf16_t* __restrict__ A, int lda, const bf16_t* __restrict__ B, int ldb, int K, int m0, int n0,
                bf16_t* sA, bf16_t* sB, Epi epi) {
  const int tid = otid(), lane = tid & 63, wave = tid >> 6;
  const int wm = wave >> 1, wn = wave & 1;
  const int lr = tid >> 3, lc = (tid & 7) * 8;
  f32x16 acc[4][2];
#pragma unroll
  for (int i = 0; i < 4; ++i)
#pragma unroll
    for (int j = 0; j < 2; ++j)
#pragma unroll
      for (int r = 0; r < 16; ++r) acc[i][j][r] = 0.f;
  u32x4 ra0, ra1, ra2, ra3, ra4, ra5, ra6, ra7, rb0, rb1, rb2, rb3;
  const bf16_t* Ap = A + (size_t)(m0 + lr) * lda + lc;
  const bf16_t* Bp = B + (size_t)(n0 + lr) * ldb + lc;
#define G256_LOAD(ko)                                                                             \
  ra0 = *(const u32x4*)(Ap + (ko)); ra1 = *(const u32x4*)(Ap + (size_t)32 * lda + (ko));          \
  ra2 = *(const u32x4*)(Ap + (size_t)64 * lda + (ko)); ra3 = *(const u32x4*)(Ap + (size_t)96 * lda + (ko));   \
  ra4 = *(const u32x4*)(Ap + (size_t)128 * lda + (ko)); ra5 = *(const u32x4*)(Ap + (size_t)160 * lda + (ko)); \
  ra6 = *(const u32x4*)(Ap + (size_t)192 * lda + (ko)); ra7 = *(const u32x4*)(Ap + (size_t)224 * lda + (ko)); \
  rb0 = *(const u32x4*)(Bp + (ko)); rb1 = *(const u32x4*)(Bp + (size_t)32 * ldb + (ko));          \
  rb2 = *(const u32x4*)(Bp + (size_t)64 * ldb + (ko)); rb3 = *(const u32x4*)(Bp + (size_t)96 * ldb + (ko));
  G256_LOAD(0)
  const int nk = K >> 6;
  for (int kt = 0; kt < nk; ++kt) {
    __syncthreads();
    *(u32x4*)(sA + (lr) * LDS_ROW + lc) = ra0; *(u32x4*)(sA + (lr + 32) * LDS_ROW + lc) = ra1;
    *(u32x4*)(sA + (lr + 64) * LDS_ROW + lc) = ra2; *(u32x4*)(sA + (lr + 96) * LDS_ROW + lc) = ra3;
    *(u32x4*)(sA + (lr + 128) * LDS_ROW + lc) = ra4; *(u32x4*)(sA + (lr + 160) * LDS_ROW + lc) = ra5;
    *(u32x4*)(sA + (lr + 192) * LDS_ROW + lc) = ra6; *(u32x4*)(sA + (lr + 224) * LDS_ROW + lc) = ra7;
    *(u32x4*)(sB + (lr) * LDS_ROW + lc) = rb0; *(u32x4*)(sB + (lr + 32) * LDS_ROW + lc) = rb1;
    *(u32x4*)(sB + (lr + 64) * LDS_ROW + lc) = rb2; *(u32x4*)(sB + (lr + 96) * LDS_ROW + lc) = rb3;
    __syncthreads();
    if (kt + 1 < nk) {
      const int ko2 = (kt + 1) * 64;
      G256_LOAD(ko2)
    }
#pragma unroll
    for (int s = 0; s < 4; ++s) {
      const int ko = s * 16 + (lane >> 5) * 8;
      bf16x8 b0 = *(const bf16x8*)(sB + (wn * 64 + (lane & 31)) * LDS_ROW + ko);
      bf16x8 b1 = *(const bf16x8*)(sB + (wn * 64 + 32 + (lane & 31)) * LDS_ROW + ko);
#pragma unroll
      for (int i = 0; i < 4; ++i) {
        bf16x8 a = *(const bf16x8*)(sA + (wm * 128 + i * 32 + (lane & 31)) * LDS_ROW + ko);
        acc[i][0] = MFMA32(a, b0, acc[i][0]);
        acc[i][1] = MFMA32(a, b1, acc[i][1]);
      }
    }
  }
#undef G256_LOAD
#pragma unroll
  for (int i = 0; i < 4; ++i)
#pragma unroll
    for (int j = 0; j < 2; ++j)
#pragma unroll
      for (int r = 0; r < 16; ++r) {
        const int m = m0 + wm * 128 + i * 32 + crow32(r, lane >> 5);
        const int n = n0 + wn * 64 + j * 32 + (lane & 31);
        epi(m, n, acc[i][j][r]);
      }
}

DI void conv32(const bf16_t* __restrict__ Pcol, int tok, int spos, const float* wl, int wstride, float* acc) {
#pragma unroll
  for (int hq = 0; hq < 2; ++hq) {
    __builtin_amdgcn_sched_barrier(0);
    uint4 v[4][2];
#pragma unroll
    for (int j = 0; j < 4; ++j) {
      const bool ok = (spos - 3 + j >= 0);
      const uint4* src = (const uint4*)(Pcol + (size_t)(tok - 3 + (ok ? j : 3)) * 4096) + 2 * hq;
#pragma unroll
      for (int q = 0; q < 2; ++q) {
        v[j][q] = src[q];
        if (!ok) v[j][q] = make_uint4(0u, 0u, 0u, 0u);
      }
    }
    f32x2 a2[8];
#pragma unroll
    for (int i = 0; i < 8; ++i) { a2[i][0] = 0.f; a2[i][1] = 0.f; }
#pragma unroll
    for (int j = 0; j < 4; ++j) {
      const float4* w4 = (const float4*)(wl + j * wstride + 16 * hq);
#pragma unroll
      for (int q = 0; q < 2; ++q) {
        const uint4 u = v[j][q];
        const float4 wa = w4[2 * q], wb = w4[2 * q + 1];
        const f32x2 f0 = {bflo(u.x), bfhi(u.x)}, f1 = {bflo(u.y), bfhi(u.y)}, f2 = {bflo(u.z), bfhi(u.z)}, f3 = {bflo(u.w), bfhi(u.w)};
        const f32x2 w0 = {wa.x, wa.y}, w1 = {wa.z, wa.w}, w2 = {wb.x, wb.y}, w3 = {wb.z, wb.w};
        a2[4 * q + 0] = __builtin_elementwise_fma(w0, f0, a2[4 * q + 0]);
        a2[4 * q + 1] = __builtin_elementwise_fma(w1, f1, a2[4 * q + 1]);
        a2[4 * q + 2] = __builtin_elementwise_fma(w2, f2, a2[4 * q + 2]);
        a2[4 * q + 3] = __builtin_elementwise_fma(w3, f3, a2[4 * q + 3]);
      }
    }
#pragma unroll
    for (int i = 0; i < 8; ++i) { acc[16 * hq + 2 * i] = a2[i][0]; acc[16 * hq + 2 * i + 1] = a2[i][1]; }
#pragma unroll
    for (int i = 0; i < 16; ++i) acc[16 * hq + i] = acc[16 * hq + i] * sigmoidf_(acc[16 * hq + i]);
  }
  __builtin_amdgcn_sched_barrier(0);
}

DI void gdn_pre(const Params& p, int ch, char* smem) {
  const int tid = otid(), lane = tid & 63, wave = tid >> 6;
  const int b = ch >> 8, h = (ch >> 6) & 3, c = ch & 63;
  const int tok0 = b * 4096 + c * 64;
  bf16_t* qh = (bf16_t*)smem;
  bf16_t* kh = qh + 64 * 136;
  float* X = (float*)smem;
  float* Amat = (float*)(smem + 34816);
  float* s_la = (float*)(smem + 34816 + 16384);
  float* s_beta = s_la + 64;
  float* s_gc = s_beta + 64;
  float* s_eg = s_gc + 64;
  float* s_w = (float*)(smem + 52224);
  const bf16_t* P = (const bf16_t*)(p.ws + OFF_P);
  const float* G = (const float*)(p.ws + OFF_G);
  char* gi = p.ws + OFF_R1 + (size_t)ch * GDN_INT_BYTES;
  for (int i = tid; i < 1536; i += 256) {
    const int j = i / 384, r = i % 384;
    s_w[i] = p.gdn_conv_w[j * 1536 + (r >> 7) * 512 + h * 128 + (r & 127)];
  }
  bf16_t* o_w = (bf16_t*)gi;
  bf16_t* o_qd = (bf16_t*)(gi + 16384);
  bf16_t* o_kdT = (bf16_t*)(gi + 32768);
  bf16_t* o_uT = (bf16_t*)(gi + 49152);
  bf16_t* o_qk = (bf16_t*)(gi + 65536);

  if (tid < 64) {
    float ga = G[(size_t)h * T_TOK + tok0 + tid], gb = G[(size_t)(4 + h) * T_TOK + tok0 + tid];
    float sp = softplusf_(ga + p.gdn_dt_bias[h]);
    float s = -__expf(p.gdn_a_log[h]) * sp;
    s_beta[tid] = sigmoidf_(gb);
#pragma unroll
    for (int d = 1; d < 64; d <<= 1) {
      const float o = __shfl_up(s, d);
      if (lane >= d) s += o;
    }
    s_gc[tid] = s;
    s_eg[tid] = __expf(s);
  }
  __syncthreads();
  const int t = tid >> 2, part = tid & 3;
  const float gct = s_gc[t], bet = s_beta[t], egt = s_eg[t], gcl = s_gc[63];
  float kk[32], vv[32];
  {
    float a[32];
    conv32(P + h * 128 + part * 32, tok0 + t, c * 64 + t, s_w + part * 32, 384, a);
    float ss = 0.f;
#pragma unroll
    for (int i = 0; i < 32; ++i) ss += a[i] * a[i];
    ss += __shfl_xor(ss, 1);
    ss += __shfl_xor(ss, 2);
    float rn = rsqrtf(ss + 1e-6f) * 0.08838834764831845f;
#pragma unroll
    for (int i = 0; i < 32; ++i) a[i] *= rn;
#pragma unroll
    for (int q = 0; q < 4; ++q) *(uint4*)(qh + t * 136 + part * 32 + 8 * q) = pack8(a + 8 * q);
#pragma unroll
    for (int i = 0; i < 32; ++i) a[i] *= egt;
#pragma unroll
    for (int q = 0; q < 4; ++q) *(uint4*)(o_qd + fragoff(t, part * 32 + 8 * q, 4)) = pack8(a + 8 * q);
  }
  {
    conv32(P + 512 + h * 128 + part * 32, tok0 + t, c * 64 + t, s_w + 128 + part * 32, 384, kk);
    float ss = 0.f;
#pragma unroll
    for (int i = 0; i < 32; ++i) ss += kk[i] * kk[i];
    ss += __shfl_xor(ss, 1);
    ss += __shfl_xor(ss, 2);
    float rn = rsqrtf(ss + 1e-6f);
#pragma unroll
    for (int i = 0; i < 32; ++i) kk[i] *= rn;
#pragma unroll
    for (int q = 0; q < 4; ++q) *(uint4*)(kh + t * 136 + part * 32 + 8 * q) = pack8(kk + 8 * q);
    const float ek = __expf(gcl - gct);
#pragma unroll
    for (int i = 0; i < 32; ++i) o_kdT[fragoff(part * 32 + i, t, 2)] = f2bf(kk[i] * ek);
  }
  __syncthreads();
  {
    const int ti = wave >> 1, tj = wave & 1;
    f32x16 accA, accQ;
#pragma unroll
    for (int r = 0; r < 16; ++r) { accA[r] = 0.f; accQ[r] = 0.f; }
#pragma unroll
    for (int s = 0; s < 8; ++s) {
      const int ko = s * 16 + (lane >> 5) * 8;
      bf16x8 bk = *(const bf16x8*)(kh + (tj * 32 + (lane & 31)) * 136 + ko);
      bf16x8 ak = *(const bf16x8*)(kh + (ti * 32 + (lane & 31)) * 136 + ko);
      bf16x8 aq = *(const bf16x8*)(qh + (ti * 32 + (lane & 31)) * 136 + ko);
      accA = MFMA32(ak, bk, accA);
      accQ = MFMA32(aq, bk, accQ);
    }
    const int j = tj * 32 + (lane & 31);
    const float gcj = s_gc[j];
#pragma unroll
    for (int r = 0; r < 16; ++r) {
      const int i = ti * 32 + crow32(r, lane >> 5);
      const float dec = (i >= j) ? __expf(s_gc[i] - gcj) : 0.f;
      Amat[i * 64 + j] = (i > j) ? s_beta[i] * accA[r] * dec : 0.f;
      o_qk[fragoff(i, j, 2)] = f2bf(accQ[r] * dec);
    }
  }
  conv32(P + 1024 + h * 128 + part * 32, tok0 + t, c * 64 + t, s_w + 256 + part * 32, 384, vv);
  __syncthreads();
  f32x2 c2[32];
#pragma unroll
  for (int q = 0; q < 8; ++q) {
    float4 v4 = make_float4(vv[4 * q] * bet, vv[4 * q + 1] * bet, vv[4 * q + 2] * bet, vv[4 * q + 3] * bet);
    *(float4*)(X + t * 132 + part * 32 + 4 * q) = v4;
  }
  __syncthreads();
  if (tid < 128) {
#pragma unroll
    for (int tt = 0; tt < 64; ++tt) c2[tt >> 1][tt & 1] = X[tt * 132 + tid];
  }
  __syncthreads();
  {
    const float f = bet * egt;
#pragma unroll
    for (int q = 0; q < 8; ++q) {
      float4 v4 = make_float4(kk[4 * q] * f, kk[4 * q + 1] * f, kk[4 * q + 2] * f, kk[4 * q + 3] * f);
      *(float4*)(X + t * 132 + part * 32 + 4 * q) = v4;
    }
  }
  __syncthreads();
  if (tid >= 128) {
#pragma unroll
    for (int tt = 0; tt < 64; ++tt) c2[tt >> 1][tt & 1] = X[tt * 132 + tid - 128];
  }
#pragma unroll
  for (int i = 1; i < 64; ++i) {
    f32x2 sa = {0.f, 0.f}, sb = {0.f, 0.f};
    const f32x2* arow = (const f32x2*)(Amat + i * 64);
#pragma unroll
    for (int k = 0; k < (i >> 1); ++k) {
      const f32x2 a2 = arow[k];
      if (k & 1) sb = __builtin_elementwise_fma(a2, c2[k], sb);
      else sa = __builtin_elementwise_fma(a2, c2[k], sa);
    }
    float tot = (sa[0] + sa[1]) + (sb[0] + sb[1]);
    if (i & 1) tot += Amat[i * 64 + i - 1] * c2[(i - 1) >> 1][0];
    c2[i >> 1][i & 1] -= tot;
    __builtin_amdgcn_sched_barrier(0);
  }
  if (tid < 128) {
#pragma unroll
    for (int q = 0; q < 16; ++q) {
      const int l = 4 * q;
      uint2 v2; v2.x = pk2(c2[2 * q][0], c2[2 * q][1]); v2.y = pk2(c2[2 * q + 1][0], c2[2 * q + 1][1]);
      *(uint2*)(o_uT + ((((tid >> 4) * 4 + (l >> 4)) * 64 + ((l >> 2) & 3) * 16 + (tid & 15)) << 2)) = v2;
    }
  } else {
    const int cc = tid - 128;
#pragma unroll
    for (int tt = 0; tt < 64; ++tt) o_w[fragoff(tt, cc, 4)] = f2bf(c2[tt >> 1][tt & 1]);
  }
  if (tid == 0) ((float*)(p.ws + OFF_GLAST))[ch] = s_eg[63];
  __syncthreads();
}

DI void mlstm_pre(const Params& p, int ch, char* smem) {
  const int tid = otid(), lane = tid & 63, wave = tid >> 6;
  const int b = ch >> 8, h = (ch >> 6) & 3, c = ch & 63;
  const int tok0 = b * 4096 + c * 64;
  bf16_t* qs = (bf16_t*)smem;
  bf16_t* ks = qs + 64 * 136;
  float* sm = (float*)(smem + 34816);
  float* s_li = sm, *s_lf = sm + 64, *s_bc = sm + 128, *s_pm = sm + 192, *s_mt = sm + 256, *s_bl = sm + 320,
        *s_md = sm + 384, *s_rs = sm + 448, *s_kw = sm + 512, *s_misc = sm + 640;
  const bf16_t* P = (const bf16_t*)(p.ws + OFF_P);
  const float* G = (const float*)(p.ws + OFF_G);
  char* mi = (char*)p.out + (size_t)ch * ML_INT_BYTES;
  bf16_t* o_q = (bf16_t*)mi;
  bf16_t* o_kwT = (bf16_t*)(mi + 16384);
  bf16_t* o_vT = (bf16_t*)(mi + 32768);
  bf16_t* o_p = (bf16_t*)(mi + 49152);
  float* ms = (float*)(p.ws + OFF_MSMALL) + (size_t)ch * 512;
  const float ib = p.mlstm_i_bias[h], fb = p.mlstm_f_bias[h];

  float* s_w = (float*)(smem + 40960);
  for (int i = tid; i < 1024; i += 256) {
    const int j = i >> 8, r = i & 255;
    s_w[i] = p.mlstm_conv_w[j * 1024 + (r >> 7) * 512 + h * 128 + (r & 127)];
  }
  {
    const int j = tid >> 2, qd = tid & 3;
    float s = 0.f, mx = -INFINITY;
    if (j < c) {
      const float4* gi4 = (const float4*)(G + (size_t)(8 + h) * T_TOK + b * 4096 + j * 64 + qd * 16);
      const float4* gf4 = (const float4*)(G + (size_t)(12 + h) * T_TOK + b * 4096 + j * 64 + qd * 16);
      float xi[16], xf[16];
#pragma unroll
      for (int i = 0; i < 4; ++i) {
        const float4 a = gi4[i], f = gf4[i];
        xi[4 * i] = a.x; xi[4 * i + 1] = a.y; xi[4 * i + 2] = a.z; xi[4 * i + 3] = a.w;
        xf[4 * i] = f.x; xf[4 * i + 1] = f.y; xf[4 * i + 2] = f.z; xf[4 * i + 3] = f.w;
      }
#pragma unroll
      for (int i = 0; i < 16; ++i) { s += logsigf_(xf[i] + fb); mx = fmaxf(mx, xi[i] + ib - s); }
    }
    const int base = lane & ~3;
    float S = 0.f, M = -INFINITY;
#pragma unroll
    for (int k = 0; k < 4; ++k) {
      const float sk = __shfl(s, base + k), mk = __shfl(mx, base + k);
      M = fmaxf(M, mk - S);
      S += sk;
    }
    if (qd == 0) { s_bl[j] = S; s_md[j] = S + M; }
  }
  if (tid < 64) {
    const float li = G[(size_t)(8 + h) * T_TOK + tok0 + tid] + ib;
    const float lf = logsigf_(G[(size_t)(12 + h) * T_TOK + tok0 + tid] + fb);
    s_li[tid] = li;
    s_rs[tid] = 0.f;
    float s = lf;
#pragma unroll
    for (int d = 1; d < 64; d <<= 1) {
      const float o = __shfl_up(s, d);
      if (lane >= d) s += o;
    }
    float pm = li - s;
#pragma unroll
    for (int d = 1; d < 64; d <<= 1) {
      const float o = __shfl_up(pm, d);
      if (lane >= d) pm = fmaxf(pm, o);
    }
    s_bc[tid] = s;
    s_pm[tid] = pm;
  }
  if (tid < 128) s_kw[tid] = 0.f;
  __syncthreads();
  if (wave == 0) {
    float a = s_bl[lane], bb = s_md[lane];
#pragma unroll
    for (int d = 1; d < 64; d <<= 1) {
      const float a2 = __shfl_up(a, d), b2 = __shfl_up(bb, d);
      if (lane >= d) { bb = fmaxf(b2 + a, bb); a = a2 + a; }
    }
    if (lane == 63) s_misc[0] = fmaxf(a, bb);
  }
  __syncthreads();
  const float m = s_misc[0];
  const float b_last = s_bc[63];
  const float m_new = fmaxf(b_last + m, b_last + s_pm[63]);
  float fl_val = 0.f;
  float* s_sc = sm + 648;
  if (tid < 64) {
    const float mt = fmaxf(s_bc[tid] + m, s_bc[tid] + s_pm[tid]);
    s_mt[tid] = mt;
    s_sc[tid] = __expf(s_bc[tid] + m - mt);
    fl_val = __expf(-mt);
  }
  if (tid == 0) ms[384] = __expf(b_last + m - m_new);
  __syncthreads();
  const int t = tid >> 2, part = tid & 3;
  const float wgt = __expf(b_last - s_bc[t] + s_li[t] - m_new);
  {
    float a[32];
    conv32(P + 2048 + h * 128 + part * 32, tok0 + t, c * 64 + t, s_w + part * 32, 256, a);
#pragma unroll
    for (int q = 0; q < 4; ++q) *(uint4*)(qs + t * 136 + part * 32 + 8 * q) = pack8(a + 8 * q);
    {
      const float sct = s_sc[t];
#pragma unroll
      for (int i = 0; i < 32; ++i) a[i] *= sct;
#pragma unroll
      for (int q = 0; q < 4; ++q) *(uint4*)(o_q + fragoff(t, part * 32 + 8 * q, 4)) = pack8(a + 8 * q);
    }
    conv32(P + 2560 + h * 128 + part * 32, tok0 + t, c * 64 + t, s_w + 128 + part * 32, 256, a);
#pragma unroll
    for (int i = 0; i < 32; ++i) a[i] *= 0.08838834764831845f;
#pragma unroll
    for (int q = 0; q < 4; ++q) *(uint4*)(ks + t * 136 + part * 32 + 8 * q) = pack8(a + 8 * q);
#pragma unroll
    for (int i = 0; i < 32; ++i) {
      bf16_t kb = f2bf(a[i] * wgt);
      o_kwT[fragoff(part * 32 + i, t, 2)] = kb;
      atomicAdd(&s_kw[part * 32 + i], bf2f(kb));
    }
    const uint4* vsrc = (const uint4*)(P + (size_t)(tok0 + t) * 4096 + 3072 + h * 128 + part * 32);
#pragma unroll
    for (int q = 0; q < 4; ++q) {
      uint4 v = vsrc[q];
      const unsigned uu[4] = {v.x, v.y, v.z, v.w};
#pragma unroll
      for (int e = 0; e < 4; ++e) {
        o_vT[fragoff(part * 32 + 8 * q + 2 * e, t, 2)] = (bf16_t)(uu[e] & 0xffffu);
        o_vT[fragoff(part * 32 + 8 * q + 2 * e + 1, t, 2)] = (bf16_t)(uu[e] >> 16);
      }
    }
  }
  __syncthreads();
  {
    const int ti = wave >> 1, tj = wave & 1;
    f32x16 acc;
#pragma unroll
    for (int r = 0; r < 16; ++r) acc[r] = 0.f;
#pragma unroll
    for (int s = 0; s < 8; ++s) {
      const int ko = s * 16 + (lane >> 5) * 8;
      bf16x8 bk = *(const bf16x8*)(ks + (tj * 32 + (lane & 31)) * 136 + ko);
      bf16x8 aq = *(const bf16x8*)(qs + (ti * 32 + (lane & 31)) * 136 + ko);
      acc = MFMA32(aq, bk, acc);
    }
    const int j = tj * 32 + (lane & 31);
    const float cj = s_li[j] - s_bc[j];
#pragma unroll
    for (int r = 0; r < 16; ++r) {
      const int i = ti * 32 + crow32(r, lane >> 5);
      float pv = (i >= j) ? acc[r] * __expf(s_bc[i] + cj - s_mt[i]) : 0.f;
      o_p[fragoff(i, j, 2)] = f2bf(pv);
      pv += __shfl_xor(pv, 1);
      pv += __shfl_xor(pv, 2);
      pv += __shfl_xor(pv, 4);
      pv += __shfl_xor(pv, 8);
      pv += __shfl_xor(pv, 16);
      if ((lane & 31) == 0) atomicAdd(&s_rs[i], pv);
    }
  }
  __syncthreads();
  if (tid < 64) { ms[tid] = s_rs[tid]; ms[64 + tid] = fl_val; }
  if (tid < 128) ms[256 + tid] = s_kw[tid];
  __syncthreads();
}

DI uint2 pack4(float a, float b, float c, float d) { uint2 o; o.x = pk2(a, b); o.y = pk2(c, d); return o; }

DI void lds_barrier() { asm volatile("s_waitcnt lgkmcnt(0)\n\ts_barrier" ::: "memory"); }

struct GdnFrag {
  bf16x8 aW[4], aQ[4], aK[2], aD[2][2];
  uint2 uu;
  float gl;
};
DI void gdn_load(GdnFrag& f, const char* gi, const float* GL, int chidx, int slice, int wave, int l16, int kg) {
  const bf16_t* w = (const bf16_t*)gi;
  const bf16_t* qd = (const bf16_t*)(gi + 16384);
  const bf16_t* kdT = (const bf16_t*)(gi + 32768);
  const bf16_t* uT = (const bf16_t*)(gi + 49152);
  const bf16_t* qk = (const bf16_t*)(gi + 65536);
  const int ln = kg * 16 + l16;
#pragma unroll
  for (int s = 0; s < 4; ++s) {
    f.aW[s] = *(const bf16x8*)(w + (((wave * 4 + s) * 64 + ln) << 3));
    f.aQ[s] = *(const bf16x8*)(qd + (((wave * 4 + s) * 64 + ln) << 3));
  }
#pragma unroll
  for (int s = 0; s < 2; ++s) {
    f.aK[s] = *(const bf16x8*)(qk + (((wave * 2 + s) * 64 + ln) << 3));
#pragma unroll
    for (int tI = 0; tI < 2; ++tI) f.aD[tI][s] = *(const bf16x8*)(kdT + ((((2 * wave + tI) * 2 + s) * 64 + ln) << 3));
  }
  f.uu = *(const uint2*)(uT + (((slice * 4 + wave) * 64 + ln) << 2));
  f.gl = GL[chidx];
}

DI void gdn_scan(const Params& p, int seq, int slice, char* smem) {
  const int tid = otid(), lane = tid & 63, wave = tid >> 6;
  const int l16 = lane & 15, kg = lane >> 4;
  bf16_t* StT = (bf16_t*)smem;
  bf16_t* vnT = StT + 16 * 136;
  for (int i = tid; i < 16 * 136; i += 256) StT[i] = 0;
  f32x4 accS[2];
#pragma unroll
  for (int r = 0; r < 4; ++r) { accS[0][r] = 0.f; accS[1][r] = 0.f; }
  const int b = seq >> 2, h = seq & 3;
  bf16_t* Pout = (bf16_t*)(p.ws + OFF_P) + (size_t)(b * 4096) * 4096 + 1024 + h * 128 + slice * 16;
  const float* GL = (const float*)(p.ws + OFF_GLAST);
  const char* gbase = p.ws + OFF_R1 + (size_t)(seq * 64) * GDN_INT_BYTES;
  auto step = [&](const GdnFrag& cur, int c) {
    f32x4 accW, accQ;
#pragma unroll
    for (int r = 0; r < 4; ++r) { accW[r] = 0.f; accQ[r] = 0.f; }
#pragma unroll
    for (int s = 0; s < 4; ++s) {
      bf16x8 bS = *(const bf16x8*)(StT + l16 * 136 + 32 * s + 8 * kg);
      accW = MFMA16(cur.aW[s], bS, accW);
      accQ = MFMA16(cur.aQ[s], bS, accQ);
    }
    {
      const uint2 uu = cur.uu;
      float v0 = bflo(uu.x) - accW[0], v1 = bfhi(uu.x) - accW[1], v2 = bflo(uu.y) - accW[2], v3 = bfhi(uu.y) - accW[3];
      *(uint2*)(vnT + l16 * 72 + 16 * wave + 4 * kg) = pack4(v0, v1, v2, v3);
    }
    lds_barrier();
    bf16x8 bV[2];
#pragma unroll
    for (int s = 0; s < 2; ++s) bV[s] = *(const bf16x8*)(vnT + l16 * 72 + 32 * s + 8 * kg);
#pragma unroll
    for (int tI = 0; tI < 2; ++tI) {
#pragma unroll
      for (int r = 0; r < 4; ++r) accS[tI][r] *= cur.gl;
#pragma unroll
      for (int s = 0; s < 2; ++s) accS[tI] = MFMA16(cur.aD[tI][s], bV[s], accS[tI]);
      *(uint2*)(StT + l16 * 136 + 32 * wave + 16 * tI + 4 * kg) = pack4(accS[tI][0], accS[tI][1], accS[tI][2], accS[tI][3]);
    }
#pragma unroll
    for (int s = 0; s < 2; ++s) accQ = MFMA16(cur.aK[s], bV[s], accQ);
#pragma unroll
    for (int r = 0; r < 4; ++r) Pout[(size_t)(c * 64 + 16 * wave + 4 * kg + r) * 4096 + l16] = f2bf(accQ[r]);
    lds_barrier();
  };
  auto ld = [&](GdnFrag& f, int c) {
    const int cc = c < 64 ? c : 63;
    gdn_load(f, gbase + (size_t)cc * GDN_INT_BYTES, GL, seq * 64 + cc, slice, wave, l16, kg);
    __builtin_amdgcn_sched_barrier(0);
  };
  GdnFrag fa, fb;
  ld(fa, 0);
  __syncthreads();
  for (int c = 0; c < 64; c += 2) {
    ld(fb, c + 1);
    step(fa, c);
    __builtin_amdgcn_sched_barrier(0);
    ld(fa, c + 2);
    step(fb, c + 1);
    __builtin_amdgcn_sched_barrier(0);
  }
  __syncthreads();
}

struct MlFrag {
  bf16x8 aQ[4], bV[2], aP[2], aK[2][2];
  float4 rs4, fl4;
  float dec, kws;
};
DI void ml_load(MlFrag& f, const char* mi, const float* ms, int slice, int tid, int wave, int l16, int kg) {
  const bf16_t* q = (const bf16_t*)mi;
  const bf16_t* kwT = (const bf16_t*)(mi + 16384);
  const bf16_t* vT = (const bf16_t*)(mi + 32768);
  const bf16_t* pp = (const bf16_t*)(mi + 49152);
  const int ln = kg * 16 + l16;
#pragma unroll
  for (int s = 0; s < 4; ++s) f.aQ[s] = *(const bf16x8*)(q + (((wave * 4 + s) * 64 + ln) << 3));
#pragma unroll
  for (int s = 0; s < 2; ++s) {
    f.bV[s] = *(const bf16x8*)(vT + (((slice * 2 + s) * 64 + ln) << 3));
    f.aP[s] = *(const bf16x8*)(pp + (((wave * 2 + s) * 64 + ln) << 3));
#pragma unroll
    for (int tI = 0; tI < 2; ++tI) f.aK[tI][s] = *(const bf16x8*)(kwT + ((((2 * wave + tI) * 2 + s) * 64 + ln) << 3));
  }
  f.rs4 = *(const float4*)(ms + 16 * wave + 4 * kg);
  f.fl4 = *(const float4*)(ms + 64 + 16 * wave + 4 * kg);
  f.dec = ms[384];
  f.kws = ms[256 + (tid & 127)];
}

DI void mlstm_scan(const Params& p, int seq, int slice, char* smem) {
  const int tid = otid(), lane = tid & 63, wave = tid >> 6;
  const int l16 = lane & 15, kg = lane >> 4;
  bf16_t* CT = (bf16_t*)smem;
  float* s_n = (float*)(smem + 16 * 136 * 2);
  bf16_t* s_nb = (bf16_t*)(smem + 16 * 136 * 2 + 512);
  for (int i = tid; i < 16 * 136; i += 256) CT[i] = 0;
  if (tid < 128) { s_n[tid] = 0.f; s_nb[tid] = 0; }
  f32x4 accC[2];
#pragma unroll
  for (int r = 0; r < 4; ++r) { accC[0][r] = 0.f; accC[1][r] = 0.f; }
  const int b = seq >> 2, h = seq & 3;
  bf16_t* Pout = (bf16_t*)(p.ws + OFF_P) + (size_t)(b * 4096) * 4096 + 3072 + h * 128 + slice * 16;
  const char* mbase = (const char*)p.out + (size_t)(seq * 64) * ML_INT_BYTES;
  const float* msbase = (const float*)(p.ws + OFF_MSMALL) + (size_t)(seq * 64) * 512;
  auto step = [&](const MlFrag& cur, int c) {
    f32x4 accN, accD;
#pragma unroll
    for (int r = 0; r < 4; ++r) { accN[r] = 0.f; accD[r] = 0.f; }
#pragma unroll
    for (int s = 0; s < 4; ++s) {
      bf16x8 bC = *(const bf16x8*)(CT + l16 * 136 + 32 * s + 8 * kg);
      accN = MFMA16(cur.aQ[s], bC, accN);
      u32x4 nb = *(const u32x4*)(s_nb + 32 * s + 8 * kg);
      if (l16 != 0) { nb[0] = 0u; nb[1] = 0u; nb[2] = 0u; nb[3] = 0u; }
      accD = MFMA16(cur.aQ[s], __builtin_bit_cast(bf16x8, nb), accD);
      if (s == 1) __builtin_amdgcn_sched_barrier(0);
    }
#pragma unroll
    for (int s = 0; s < 2; ++s) accN = MFMA16(cur.aP[s], cur.bV[s], accN);
    const float rsv[4] = {cur.rs4.x, cur.rs4.y, cur.rs4.z, cur.rs4.w};
    const float flv[4] = {cur.fl4.x, cur.fl4.y, cur.fl4.z, cur.fl4.w};
#pragma unroll
    for (int r = 0; r < 4; ++r) {
      const float qnr = __shfl(accD[r], lane & 48);
      const int l = 16 * wave + 4 * kg + r;
      const float den = qnr + rsv[r];
      const float hv = accN[r] * __builtin_amdgcn_rcpf(fmaxf(fabsf(den), flv[r]));
      Pout[(size_t)(c * 64 + l) * 4096 + l16] = f2bf(hv);
    }
    lds_barrier();
    const float dec = cur.dec;
#pragma unroll
    for (int tI = 0; tI < 2; ++tI) {
#pragma unroll
      for (int r = 0; r < 4; ++r) accC[tI][r] *= dec;
#pragma unroll
      for (int s = 0; s < 2; ++s) accC[tI] = MFMA16(cur.aK[tI][s], cur.bV[s], accC[tI]);
      *(uint2*)(CT + l16 * 136 + 32 * wave + 16 * tI + 4 * kg) = pack4(accC[tI][0], accC[tI][1], accC[tI][2], accC[tI][3]);
    }
    if (tid < 128) {
      const float nn = dec * s_n[tid] + cur.kws;
      s_n[tid] = nn;
      s_nb[tid] = f2bf(nn);
    }
    lds_barrier();
  };
  auto ld = [&](MlFrag& f, int c) {
    const int cc = c < 64 ? c : 63;
    ml_load(f, mbase + (size_t)cc * ML_INT_BYTES, msbase + (size_t)cc * 512, slice, tid, wave, l16, kg);
    __builtin_amdgcn_sched_barrier(0);
  };
  MlFrag fa, fb;
  ld(fa, 0);
  __syncthreads();
  for (int c = 0; c < 64; c += 2) {
    ld(fb, c + 1);
    step(fa, c);
    __builtin_amdgcn_sched_barrier(0);
    ld(fa, c + 2);
    step(fb, c + 1);
    __builtin_amdgcn_sched_barrier(0);
  }
  __syncthreads();
}

DI void gate_phase(const Params& p) {
  const int tid_ = otid(); const int lane = tid_ & 63, wave = tid_ >> 6;
  const bf16_t* P = (const bf16_t*)(p.ws + OFF_P);
  bf16_t* MX = (bf16_t*)(p.ws + OFF_MX);
  const int hh = lane >> 3, part = lane & 7;
  const bool gdn = hh < 4;
  const int ocol = (gdn ? (1024 + hh * 128) : (3072 + (hh - 4) * 128)) + part * 16;
  const int gcol = (gdn ? (1536 + hh * 128) : (3584 + (hh - 4) * 128)) + part * 16;
  const float* wp = gdn ? (p.gdn_norm_w + part * 16) : (p.mlstm_norm_w + (hh - 4) * 128 + part * 16);
  float w[16];
#pragma unroll
  for (int j = 0; j < 4; ++j) {
    const float4 t4 = ((const float4*)wp)[j];
    w[4 * j] = t4.x; w[4 * j + 1] = t4.y; w[4 * j + 2] = t4.z; w[4 * j + 3] = t4.w;
  }
  for (int tok = blockIdx.x * 4 + wave; tok < T_TOK; tok += gridDim.x * 4) {
    const bf16_t* row = P + (size_t)tok * 4096;
    const uint4 oa = *(const uint4*)(row + ocol), ob = *(const uint4*)(row + ocol + 8);
    const uint4 ga = *(const uint4*)(row + gcol), gb = *(const uint4*)(row + gcol + 8);
    float o[16], g[16];
    unpack8(oa, o); unpack8(ob, o + 8);
    unpack8(ga, g); unpack8(gb, g + 8);
    float ss = 0.f;
#pragma unroll
    for (int k = 0; k < 16; ++k) ss += o[k] * o[k];
    ss += __shfl_xor(ss, 1);
    ss += __shfl_xor(ss, 2);
    ss += __shfl_xor(ss, 4);
    const float r = rsqrtf(ss * (1.f / 128.f) + 1e-6f);
    float y[16];
#pragma unroll
    for (int k = 0; k < 16; ++k) {
      const float sg = sigmoidf_(g[k]);
      const float a = gdn ? g[k] * sg : sg;
      y[k] = o[k] * r * w[k] * a;
    }
    bf16_t* dst = MX + (size_t)tok * 1024 + hh * 128 + part * 16;
    *(uint4*)dst = pack8(y);
    *(uint4*)(dst + 8) = pack8(y + 8);
  }
}

DI void attn_item(const Params& p, int item, char* smem) {
  const int tid = otid(), lane = tid & 63, wave = tid >> 6;
  const int l32 = lane & 31, half = lane >> 5;
  const int qt = item & 31, h = (item >> 5) & 3, b = item >> 7;
  const bf16_t* Qx = (const bf16_t*)(p.ws + OFF_QX);
  const bf16_t* Kb = (const bf16_t*)(p.ws + OFF_KB);
  const bf16_t* VT = (const bf16_t*)(p.ws + OFF_VT);
  bf16_t* AO = (bf16_t*)(p.ws + OFF_AO);
  bf16_t* Kc = (bf16_t*)smem;
  const int tokbase = b * 4096 + qt * 128 + 32 * wave;
  bf16x8 bq[16];
#pragma unroll
  for (int s = 0; s < 16; ++s) bq[s] = *(const bf16x8*)(Qx + (size_t)(tokbase + l32) * 1024 + h * 256 + 16 * s + 8 * half);
  f32x16 sacc[8];
#pragma unroll
  for (int jt = 0; jt < 8; ++jt)
#pragma unroll
    for (int r = 0; r < 16; ++r) sacc[jt][r] = 0.f;
#pragma unroll
  for (int c = 0; c < 4; ++c) {
    __syncthreads();
#pragma unroll
    for (int hf = 0; hf < 2; ++hf) {
      u32x4 st[4];
#pragma unroll
      for (int i = 0; i < 4; ++i) {
        const int row = (tid >> 5) + 8 * (4 * hf + i);
        st[i] = *(const u32x4*)(Kb + (size_t)(b * 256 + 64 * c + row) * 1024 + h * 256 + (tid & 31) * 8);
      }
#pragma unroll
      for (int i = 0; i < 4; ++i) {
        const int row = (tid >> 5) + 8 * (4 * hf + i);
        *(u32x4*)(Kc + row * 264 + (tid & 31) * 8) = st[i];
      }
    }
    __syncthreads();
#pragma unroll
    for (int jt2 = 0; jt2 < 2; ++jt2)
#pragma unroll
      for (int s = 0; s < 16; ++s) {
        const bf16x8 a = *(const bf16x8*)(Kc + (jt2 * 32 + l32) * 264 + 16 * s + 8 * half);
        sacc[2 * c + jt2] = MFMA32(a, bq[s], sacc[2 * c + jt2]);
      }
  }
  float mx = sacc[0][0];
#pragma unroll
  for (int jt = 0; jt < 8; ++jt)
#pragma unroll
    for (int r = 0; r < 16; ++r) mx = fmaxf(mx, sacc[jt][r]);
  mx = fmaxf(mx, __shfl_xor(mx, 32));
  float sum = 0.f;
  bf16x8 pf[8][2];
#pragma unroll
  for (int jt = 0; jt < 8; ++jt) {
#pragma unroll
    for (int ks = 0; ks < 2; ++ks) {
      float e[8];
#pragma unroll
      for (int k = 0; k < 8; ++k) {
        e[k] = __expf((sacc[jt][8 * ks + k] - mx) * 0.0625f);
        sum += e[k];
      }
      u32x4 pk;
      pk[0] = pk2(e[0], e[1]); pk[1] = pk2(e[2], e[3]); pk[2] = pk2(e[4], e[5]); pk[3] = pk2(e[6], e[7]);
      pf[jt][ks] = __builtin_bit_cast(bf16x8, pk);
    }
  }
  sum += __shfl_xor(sum, 32);
  const float inv = 1.f / sum;
  f32x16 oacc[8];
#pragma unroll
  for (int dt = 0; dt < 8; ++dt)
#pragma unroll
    for (int r = 0; r < 16; ++r) oacc[dt][r] = 0.f;
#pragma unroll
  for (int c = 0; c < 4; ++c) {
    __syncthreads();
#pragma unroll
    for (int hf = 0; hf < 2; ++hf) {
      u32x4 st[4];
#pragma unroll
      for (int i = 0; i < 4; ++i) {
        const int row = (tid >> 3) + 32 * (4 * hf + i);
        st[i] = *(const u32x4*)(VT + (size_t)((b * 4 + h) * 256 + row) * 256 + 64 * c + (tid & 7) * 8);
      }
#pragma unroll
      for (int i = 0; i < 4; ++i) {
        const int row = (tid >> 3) + 32 * (4 * hf + i);
        *(u32x4*)(Kc + row * 72 + (tid & 7) * 8) = st[i];
      }
    }
    __syncthreads();
#pragma unroll
    for (int jt2 = 0; jt2 < 2; ++jt2)
#pragma unroll
      for (int ks = 0; ks < 2; ++ks) {
        const bf16x8 bp = pf[2 * c + jt2][ks];
#pragma unroll
        for (int dt = 0; dt < 8; ++dt) {
          const bf16_t* vp = Kc + (32 * dt + l32) * 72 + 32 * jt2 + 16 * ks + 4 * half;
          const uint2 lo = *(const uint2*)vp, hi = *(const uint2*)(vp + 8);
          u32x4 av; av[0] = lo.x; av[1] = lo.y; av[2] = hi.x; av[3] = hi.y;
          oacc[dt] = MFMA32(__builtin_bit_cast(bf16x8, av), bp, oacc[dt]);
        }
      }
  }
  bf16_t* orow = AO + (size_t)(tokbase + l32) * 1024 + h * 256;
#pragma unroll
  for (int dt = 0; dt < 8; ++dt)
#pragma unroll
    for (int g4 = 0; g4 < 4; ++g4) {
      uint2 o;
      o.x = pk2(oacc[dt][4 * g4] * inv, oacc[dt][4 * g4 + 1] * inv);
      o.y = pk2(oacc[dt][4 * g4 + 2] * inv, oacc[dt][4 * g4 + 3] * inv);
      *(uint2*)(orow + 32 * dt + 8 * g4 + 4 * half) = o;
    }
  __syncthreads();
}

DI unsigned f2key(float f) {
  unsigned u = __float_as_uint(f);
  return (u & 0x80000000u) ? ~u : (u | 0x80000000u);
}
DI float key2f(unsigned k) {
  unsigned u = (k & 0x80000000u) ? (k & 0x7fffffffu) : ~k;
  return __uint_as_float(u);
}
DI void sort16_desc(unsigned* a) {
#pragma unroll
  for (int k = 2; k <= 16; k <<= 1)
#pragma unroll
    for (int j = k >> 1; j >= 1; j >>= 1)
#pragma unroll
      for (int i = 0; i < 16; ++i) {
        const int l = i ^ j;
        if (l > i) {
          const unsigned hi = max(a[i], a[l]), lo = min(a[i], a[l]);
          if ((i & k) == 0) { a[i] = hi; a[l] = lo; } else { a[i] = lo; a[l] = hi; }
        }
      }
}
DI void merge16_desc(unsigned* lst, const unsigned* oth) {
#pragma unroll
  for (int i = 0; i < 16; ++i) lst[i] = max(lst[i], oth[15 - i]);
#pragma unroll
  for (int st = 8; st >= 1; st >>= 1)
#pragma unroll
    for (int i = 0; i < 16; ++i)
      if ((i & st) == 0) {
        const unsigned hi = max(lst[i], lst[i + st]), lo = min(lst[i], lst[i + st]);
        lst[i] = hi;
        lst[i + st] = lo;
      }
}
DI void insert16(unsigned* lst, unsigned x) {
#pragma unroll
  for (int i = 0; i < 16; ++i) {
    unsigned hi = max(lst[i], x);
    x = min(lst[i], x);
    lst[i] = hi;
  }
}

DI void peer_route_item(const Params& p, int item, char* smem) {
  const int tid = otid(), lane = tid & 63, wave = tid >> 6;
  const int wm = wave >> 1, wn = wave & 1;
  const int mt = item >> 3, h = item & 7;
  const bf16_t* H3 = (const bf16_t*)(p.ws + OFF_H3);
  const bf16_t* PWqT = (const bf16_t*)(p.ws + OFF_PWQT);
  const bf16_t* SKb = (const bf16_t*)(p.ws + OFF_SKB);
  int* EID = (int*)(p.ws + OFF_EID);
  float* GATE = (float*)(p.ws + OFF_GATE);
  bf16_t* sA = (bf16_t*)smem;
  bf16_t* sB = (bf16_t*)(smem + 18432);
  bf16_t* Qs = (bf16_t*)(smem + 36864);
  unsigned* skey = (unsigned*)smem;
  unsigned char* itab = (unsigned char*)(smem + 71680);
  unsigned lst[2][16];
  const int token = tid >> 1, half = tid & 1;
#pragma unroll
  for (int pp = 0; pp < 2; ++pp) {
    const int m0 = mt * 128, n0 = (h * 2 + pp) * 128;
    gemm128(H3, 1024, PWqT, 1024, 1024, m0, n0, sA, sB,
            [&](int m, int n, float v) { Qs[(m - m0) * 136 + (n - n0)] = f2bf(v); });
    __syncthreads();
    f32x16 acc[2][2];
#pragma unroll
    for (int i = 0; i < 2; ++i)
#pragma unroll
      for (int j = 0; j < 2; ++j)
#pragma unroll
        for (int r = 0; r < 16; ++r) acc[i][j][r] = 0.f;
    const bf16_t* skp = SKb + (size_t)(h * 2 + pp) * 128 * 128;
#pragma unroll
    for (int s = 0; s < 8; ++s) {
      const int ko = s * 16 + (lane >> 5) * 8;
      bf16x8 a0 = *(const bf16x8*)(Qs + (wm * 64 + (lane & 31)) * 136 + ko);
      bf16x8 a1 = *(const bf16x8*)(Qs + (wm * 64 + 32 + (lane & 31)) * 136 + ko);
      bf16x8 b0 = *(const bf16x8*)(skp + (wn * 64 + (lane & 31)) * 128 + ko);
      bf16x8 b1 = *(const bf16x8*)(skp + (wn * 64 + 32 + (lane & 31)) * 128 + ko);
      acc[0][0] = MFMA32(a0, b0, acc[0][0]);
      acc[0][1] = MFMA32(a0, b1, acc[0][1]);
      acc[1][0] = MFMA32(a1, b0, acc[1][0]);
      acc[1][1] = MFMA32(a1, b1, acc[1][1]);
    }
    __syncthreads();
#pragma unroll
    for (int i = 0; i < 2; ++i)
#pragma unroll
      for (int j = 0; j < 2; ++j)
#pragma unroll
        for (int r = 0; r < 16; ++r) {
          const int row = wm * 64 + i * 32 + crow32(r, lane >> 5);
          const int colk = wn * 64 + j * 32 + (lane & 31);
          skey[row * 129 + colk] = (f2key(acc[i][j][r]) & ~127u) | (unsigned)(127 - colk);
        }
    __syncthreads();
    {
      const unsigned* kp = skey + token * 129 + half * 64;
#pragma unroll
      for (int i = 0; i < 16; ++i) lst[pp][i] = kp[i];
      sort16_desc(lst[pp]);
#pragma unroll 1
      for (int bt = 1; bt < 4; ++bt) {
        unsigned bb[16];
#pragma unroll
        for (int i = 0; i < 16; ++i) bb[i] = kp[bt * 16 + i];
        sort16_desc(bb);
        merge16_desc(lst[pp], bb);
      }
      unsigned oth[16];
#pragma unroll
      for (int i = 0; i < 16; ++i) oth[i] = __shfl_xor(lst[pp][i], 1);
      merge16_desc(lst[pp], oth);
    }
    __syncthreads();
  }
  if (half == 0) {
#pragma unroll
    for (int i = 0; i < 16; ++i) {
      itab[token * 32 + i] = (unsigned char)(127 - (lst[0][i] & 127u));
      itab[token * 32 + 16 + i] = (unsigned char)(127 - (lst[1][i] & 127u));
    }
  }
  float v0[16], v1[16];
#pragma unroll
  for (int i = 0; i < 16; ++i) {
    v0[i] = key2f(lst[0][i] & ~127u);
    v1[i] = key2f(lst[1][i] & ~127u);
  }
  unsigned best[16];
#pragma unroll
  for (int i = 0; i < 16; ++i) best[i] = (f2key(v0[i] + v1[0]) & ~255u) | (unsigned)(255 - i * 16);
#pragma unroll
  for (int i = 0; i < 16; ++i)
#pragma unroll
    for (int j = 1; j < 16; ++j)
      if ((i + 1) * (j + 1) <= 16) insert16(best, (f2key(v0[i] + v1[j]) & ~255u) | (unsigned)(255 - (i * 16 + j)));
  __syncthreads();
  float bv[16];
  float ssum = 0.f;
  const float vmax = key2f(best[0] & ~255u);
#pragma unroll
  for (int i = 0; i < 16; ++i) {
    bv[i] = __expf(key2f(best[i] & ~255u) - vmax);
    ssum += bv[i];
  }
  const float inv = 1.f / ssum;
  const size_t obase = ((size_t)(mt * 128 + token) * 8 + h) * 16;
  if (half == 0) {
#pragma unroll
    for (int i = 0; i < 8; ++i) {
      const int pay = 255 - (int)(best[i] & 255u);
      const int e = (int)itab[token * 32 + (pay >> 4)] * 128 + (int)itab[token * 32 + 16 + (pay & 15)];
      EID[obase + i] = e;
      GATE[obase + i] = bv[i] * inv;
    }
  } else {
#pragma unroll
    for (int i = 8; i < 16; ++i) {
      const int pay = 255 - (int)(best[i] & 255u);
      const int e = (int)itab[token * 32 + (pay >> 4)] * 128 + (int)itab[token * 32 + 16 + (pay & 15)];
      EID[obase + i] = e;
      GATE[obase + i] = bv[i] * inv;
    }
  }
  __syncthreads();
}

DI void convert_rows_fp8(const float* __restrict__ src, unsigned char* __restrict__ dst, float* __restrict__ scales, int nrows) {
  const int tid_ = otid();
  const int lane = tid_ & 63, wave = tid_ >> 6;
  for (int r = blockIdx.x * 4 + wave; r < nrows; r += gridDim.x * 4) {
    const float4* s = (const float4*)(src + (size_t)r * 1024 + 16 * lane);
    float4 v[4];
    float am = 0.f;
#pragma unroll
    for (int j = 0; j < 4; ++j) {
      v[j] = s[j];
      am = fmaxf(am, fmaxf(fmaxf(fabsf(v[j].x), fabsf(v[j].y)), fmaxf(fabsf(v[j].z), fabsf(v[j].w))));
    }
#pragma unroll
    for (int o = 32; o >= 1; o >>= 1) am = fmaxf(am, __shfl_xor(am, o));
    const float sc = (am > 0.f) ? am * (1.f / 384.f) : 1.f;
    const float inv = 1.f / sc;
    u32x4 o4;
#pragma unroll
    for (int j = 0; j < 4; ++j) {
      int pk = __builtin_amdgcn_cvt_pk_fp8_f32(v[j].x * inv, v[j].y * inv, 0, false);
      pk = __builtin_amdgcn_cvt_pk_fp8_f32(v[j].z * inv, v[j].w * inv, pk, true);
      o4[j] = (unsigned)pk;
    }
    *(u32x4*)(dst + (size_t)(lane >> 3) * (16384 * 128) + (size_t)r * 128 + 16 * (lane & 7)) = o4;
    if (lane == 0) scales[r] = sc;
  }
}
DI void unpack16_fp8(const u32x4& a, float* f) {
#pragma unroll
  for (int j = 0; j < 4; ++j) {
    f32x2 lo = __builtin_amdgcn_cvt_pk_f32_fp8((int)a[j], false);
    f32x2 hi = __builtin_amdgcn_cvt_pk_f32_fp8((int)a[j], true);
    f[4 * j] = lo[0]; f[4 * j + 1] = lo[1]; f[4 * j + 2] = hi[0]; f[4 * j + 3] = hi[1];
  }
}
struct PeerRows { u32x4 u[16]; uint4 xa, xb; };
DI void peer_load_e(int* e, const int* EID, int tok, int q) {
  const int4* ep = (const int4*)(EID + (size_t)tok * 128 + 16 * q);
#pragma unroll
  for (int j = 0; j < 4; ++j) { const int4 v = ep[j]; e[4 * j] = v.x; e[4 * j + 1] = v.y; e[4 * j + 2] = v.z; e[4 * j + 3] = v.w; }
}
DI void peer_u_phase(const Params& p) {
  const int tid_ = otid();
  const int lane = tid_ & 63, wave = tid_ >> 6;
  const int g = blockIdx.x & 7, rank = blockIdx.x >> 3, nrank = gridDim.x >> 3;
  if (rank >= nrank) return;
  const int q = lane >> 3, s = lane & 7;
  const bf16_t* H3 = (const bf16_t*)(p.ws + OFF_H3) + 128 * g + 16 * s;
  const unsigned char* Ub = (const unsigned char*)(p.ws + OFF_UB) + (size_t)g * (16384 * 128) + 16 * s;
  const int* EID = (const int*)(p.ws + OFF_EID);
  float* PART = (float*)(p.ws + OFF_PART) + (size_t)g * T_TOK * 128;
  const int first = rank * 4 + wave, stride = nrank * 4;
  const int n = (T_TOK - first + stride - 1) / stride;
  auto tokof = [&](int k) { return first + (k < n ? k : n - 1) * stride; };
  auto gather = [&](PeerRows& r, const int* e, int tok) {
#pragma unroll
    for (int i = 0; i < 16; ++i) r.u[i] = *(const u32x4*)(Ub + (size_t)e[i] * 128);
    r.xa = *(const uint4*)(H3 + (size_t)tok * 1024);
    r.xb = *(const uint4*)(H3 + (size_t)tok * 1024 + 8);
  };
  auto compute = [&](const PeerRows& r, int tok) {
    f32x2 x2[8];
    {
      float x[16];
      unpack8(r.xa, x);
      unpack8(r.xb, x + 8);
#pragma unroll
      for (int k = 0; k < 8; ++k) { x2[k][0] = x[2 * k]; x2[k][1] = x[2 * k + 1]; }
    }
    float pr[16];
#pragma unroll
    for (int i = 0; i < 16; ++i) {
      f32x2 aA = {0.f, 0.f}, aB = {0.f, 0.f};
#pragma unroll
      for (int j = 0; j < 4; ++j) {
        const f32x2 lo = __builtin_amdgcn_cvt_pk_f32_fp8((int)r.u[i][j], false);
        const f32x2 hi = __builtin_amdgcn_cvt_pk_f32_fp8((int)r.u[i][j], true);
        aA = __builtin_elementwise_fma(lo, x2[2 * j], aA);
        aB = __builtin_elementwise_fma(hi, x2[2 * j + 1], aB);
      }
      aA += aB;
      pr[i] = aA[0] + aA[1];
    }
    float r8[8], r4[4], r2[2];
#pragma unroll
    for (int k = 0; k < 8; ++k) {
      const float keep = (lane & 4) ? pr[k + 8] : pr[k], send = (lane & 4) ? pr[k] : pr[k + 8];
      r8[k] = keep + __shfl_xor(send, 4);
    }
#pragma unroll
    for (int k = 0; k < 4; ++k) {
      const float keep = (lane & 2) ? r8[k + 4] : r8[k], send = (lane & 2) ? r8[k] : r8[k + 4];
      r4[k] = keep + __shfl_xor(send, 2);
    }
#pragma unroll
    for (int k = 0; k < 2; ++k) {
      const float keep = (lane & 1) ? r4[k + 2] : r4[k], send = (lane & 1) ? r4[k] : r4[k + 2];
      r2[k] = keep + __shfl_xor(send, 1);
    }
    *(float2*)(PART + (size_t)tok * 128 + 2 * lane) = make_float2(r2[0], r2[1]);
  };
  int ea[16], eb[16];
  PeerRows ga, gb;
  peer_load_e(ea, EID, tokof(0), q);
  peer_load_e(eb, EID, tokof(1), q);
  gather(ga, ea, tokof(0));
  for (int k = 0; k < n; k += 2) {
    peer_load_e(ea, EID, tokof(k + 2), q);
    gather(gb, eb, tokof(k + 1));
    __builtin_amdgcn_sched_barrier(0);
    compute(ga, tokof(k));
    __builtin_amdgcn_sched_barrier(0);
    peer_load_e(eb, EID, tokof(k + 3), q);
    gather(ga, ea, tokof(k + 2));
    __builtin_amdgcn_sched_barrier(0);
    if (k + 1 < n) compute(gb, tokof(k + 1));
    __builtin_amdgcn_sched_barrier(0);
  }
}
DI void peer_w_phase(const Params& p) {
  const int tid_ = otid();
  const int lane = tid_ & 63, wave = tid_ >> 6;
  const float* PART = (const float*)(p.ws + OFF_PART);
  const float* Usc = (const float*)(p.ws + OFF_USC);
  const float* Vsc = (const float*)(p.ws + OFF_VSC);
  const int* EID = (const int*)(p.ws + OFF_EID);
  const float* GATE = (const float*)(p.ws + OFF_GATE);
  float* W = (float*)(p.ws + OFF_W);
  for (int tok = blockIdx.x * 4 + wave; tok < T_TOK; tok += gridDim.x * 4) {
    float t0 = 0.f, t1 = 0.f;
#pragma unroll
    for (int g = 0; g < 8; ++g) {
      const float2 v = *(const float2*)(PART + ((size_t)g * T_TOK + tok) * 128 + 2 * lane);
      t0 += v.x; t1 += v.y;
    }
    const int2 e = *(const int2*)(EID + (size_t)tok * 128 + 2 * lane);
    const float2 gt = *(const float2*)(GATE + (size_t)tok * 128 + 2 * lane);
    t0 *= Usc[e.x]; t1 *= Usc[e.y];
    const float a0 = 0.5f * t0 * (1.f + erff(t0 * 0.7071067811865476f));
    const float a1 = 0.5f * t1 * (1.f + erff(t1 * 0.7071067811865476f));
    *(float2*)(W + (size_t)tok * 128 + 2 * lane) = make_float2(gt.x * a0 * Vsc[e.x], gt.y * a1 * Vsc[e.y]);
  }
}
struct PeerVRows { u32x4 v[16]; float4 w[4]; };
DI void peer_v_phase(const Params& p) {
  const int tid_ = otid();
  const int lane = tid_ & 63, wave = tid_ >> 6;
  const int g = blockIdx.x & 7, rank = blockIdx.x >> 3, nrank = gridDim.x >> 3;
  if (rank >= nrank) return;
  const int q = lane >> 3, s = lane & 7;
  const unsigned char* Vb = (const unsigned char*)(p.ws + OFF_VB) + (size_t)g * (16384 * 128) + 16 * s;
  const int* EID = (const int*)(p.ws + OFF_EID);
  const float* W = (const float*)(p.ws + OFF_W);
  float* SSP = (float*)(p.ws + OFF_SSP) + (size_t)g * T_TOK;
  const int first = rank * 4 + wave, stride = nrank * 4;
  const int n = (T_TOK - first + stride - 1) / stride;
  auto tokof = [&](int k) { return first + (k < n ? k : n - 1) * stride; };
  auto gather = [&](PeerVRows& r, const int* e, int tok) {
#pragma unroll
    for (int i = 0; i < 16; ++i) r.v[i] = *(const u32x4*)(Vb + (size_t)e[i] * 128);
    const float4* wp = (const float4*)(W + (size_t)tok * 128 + 16 * q);
#pragma unroll
    for (int j = 0; j < 4; ++j) r.w[j] = wp[j];
  };
  auto compute = [&](const PeerVRows& r, int tok) {
    f32x2 o2[8];
#pragma unroll
    for (int k = 0; k < 8; ++k) { o2[k][0] = 0.f; o2[k][1] = 0.f; }
#pragma unroll
    for (int i = 0; i < 16; ++i) {
      const float wi = (i & 3) == 0 ? r.w[i >> 2].x : (i & 3) == 1 ? r.w[i >> 2].y : (i & 3) == 2 ? r.w[i >> 2].z : r.w[i >> 2].w;
      const f32x2 w2 = {wi, wi};
#pragma unroll
      for (int j = 0; j < 4; ++j) {
        const f32x2 lo = __builtin_amdgcn_cvt_pk_f32_fp8((int)r.v[i][j], false);
        const f32x2 hi = __builtin_amdgcn_cvt_pk_f32_fp8((int)r.v[i][j], true);
        o2[2 * j] = __builtin_elementwise_fma(lo, w2, o2[2 * j]);
        o2[2 * j + 1] = __builtin_elementwise_fma(hi, w2, o2[2 * j + 1]);
      }
    }
    float o[16];
#pragma unroll
    for (int k = 0; k < 8; ++k) { o[2 * k] = o2[k][0]; o[2 * k + 1] = o2[k][1]; }
    float r8[8], r4[4], r2[2];
#pragma unroll
    for (int k = 0; k < 8; ++k) {
      const float keep = (lane & 32) ? o[k + 8] : o[k], send = (lane & 32) ? o[k] : o[k + 8];
      r8[k] = keep + __shfl_xor(send, 32);
    }
#pragma unroll
    for (int k = 0; k < 4; ++k) {
      const float keep = (lane & 16) ? r8[k + 4] : r8[k], send = (lane & 16) ? r8[k] : r8[k + 4];
      r4[k] = keep + __shfl_xor(send, 16);
    }
#pragma unroll
    for (int k = 0; k < 2; ++k) {
      const float keep = (lane & 8) ? r4[k + 2] : r4[k], send = (lane & 8) ? r4[k] : r4[k + 2];
      r2[k] = keep + __shfl_xor(send, 8);
    }
    float* xr = p.out + (size_t)tok * 1024 + 128 * g + 16 * s + 2 * q;
    float2 y = *(const float2*)xr;
    y.x += r2[0]; y.y += r2[1];
    *(float2*)xr = y;
    const float ss = wave_sum(y.x * y.x + y.y * y.y);
    if (lane == 0) SSP[tok] = ss;
  };
  int ea[16], eb[16];
  PeerVRows ga, gb;
  peer_load_e(ea, EID, tokof(0), q);
  peer_load_e(eb, EID, tokof(1), q);
  gather(ga, ea, tokof(0));
  for (int k = 0; k < n; k += 2) {
    peer_load_e(ea, EID, tokof(k + 2), q);
    gather(gb, eb, tokof(k + 1));
    __builtin_amdgcn_sched_barrier(0);
    compute(ga, tokof(k));
    __builtin_amdgcn_sched_barrier(0);
    peer_load_e(eb, EID, tokof(k + 3), q);
    gather(ga, ea, tokof(k + 2));
    __builtin_amdgcn_sched_barrier(0);
    if (k + 1 < n) compute(gb, tokof(k + 1));
    __builtin_amdgcn_sched_barrier(0);
  }
}
DI void final_norm_phase(const Params& p) {
  const int tid_ = otid();
  const int lane = tid_ & 63, wave = tid_ >> 6;
  const float* SSP = (const float*)(p.ws + OFF_SSP);
  for (int tok = blockIdx.x * 4 + wave; tok < T_TOK; tok += gridDim.x * 4) {
    float ss = 0.f;
#pragma unroll
    for (int g = 0; g < 8; ++g) ss += SSP[(size_t)g * T_TOK + tok];
    const float rr = rsqrtf(ss * (1.f / 1024.f) + 1e-6f);
    float4* xr = (float4*)(p.out + (size_t)tok * 1024);
    const float4* fw = (const float4*)p.norm_final_w;
#pragma unroll
    for (int j = 0; j < 4; ++j) {
      float4 v = xr[lane + 64 * j];
      const float4 w4 = fw[lane + 64 * j];
      v.x *= rr * w4.x; v.y *= rr * w4.y; v.z *= rr * w4.z; v.w *= rr * w4.w;
      xr[lane + 64 * j] = v;
    }
  }
}

#ifndef LAST_PHASE
#define LAST_PHASE 99
#endif
__global__ void __launch_bounds__(256, 2) hymba_mega(Params p) {
  cg::grid_group grid = cg::this_grid();
  __shared__ __attribute__((aligned(16))) char smem[SMEM_BYTES];
  __shared__ uint4 xb_words;
  bf16_t* sA = (bf16_t*)smem;
  bf16_t* sB = (bf16_t*)(smem + 18432);
  char* ws = p.ws;
  if (ws == nullptr) grid.sync();
  if (threadIdx.x == 0) xb_words = make_uint4(0u, 0u, 0u, 0u);
  __syncthreads();
  const XcdBarrier xb = xcd_barrier_post((unsigned*)(ws + OFF_BAR), (volatile LAS unsigned*)&xb_words);

  transpose_all(p.w_in, 1024, 4112, (bf16_t*)(ws + OFF_WINT), 4112, 1, (float*)smem);
  transpose_all(p.w_out, 1024, 1024, (bf16_t*)(ws + OFF_WOUTT), 1024, 0, (float*)smem);
  transpose_all(p.xa_wq, 1024, 1024, (bf16_t*)(ws + OFF_WQT), 1024, 0, (float*)smem);
  transpose_all(p.xa_wkv, 1024, 2048, (bf16_t*)(ws + OFF_WKVT), 2048, 0, (float*)smem);
  transpose_all(p.xa_wo, 1024, 1024, (bf16_t*)(ws + OFF_WOT), 1024, 0, (float*)smem);
  transpose_all(p.peer_wq, 1024, 2048, (bf16_t*)(ws + OFF_PWQT), 2048, 0, (float*)smem);
  convert_f32_bf16(p.peer_sub_keys, (bf16_t*)(ws + OFF_SKB), 8 * 2 * 128 * 128 / 4);
  rmsnorm_rows(p.x, p.norm_mix_w, (bf16_t*)p.out, T_TOK);
  rmsnorm_rows(p.mem, p.norm_mem_w, (bf16_t*)(ws + OFF_MEMN), 1024);
  xcd_barrier(xb);

  {
    bf16_t* Pb = (bf16_t*)(ws + OFF_P);
    float* G = (float*)(ws + OFF_G);
    bf16_t* sB2 = (bf16_t*)(smem + 36864);
    for (int tile = blockIdx.x; tile < 2048 + 128; tile += gridDim.x) {
      if (tile < 2048) {
        const int mt = (tile & 7) * 8 + ((tile >> 6) & 7), nt = (tile >> 9) * 8 + ((tile >> 3) & 7);
        gemm256((const bf16_t*)p.out, 1024, (const bf16_t*)(ws + OFF_WINT), 1024, 1024, mt * 256, nt * 128, sA, sB2,
                [&](int m, int n, float v) { Pb[(size_t)m * 4096 + n] = f2bf(v); });
      } else {
        const int mt = tile - 2048;
        gemm128((const bf16_t*)p.out, 1024, (const bf16_t*)(ws + OFF_WINT), 1024, 1024, mt * 128, 4096, sA, sB,
                [&](int m, int n, float v) { if (n < 4112) G[(size_t)(n - 4096) * T_TOK + m] = v; });
      }
    }
  }
  xcd_barrier(xb);
  if (LAST_PHASE < 2) return;

  for (int it = blockIdx.x; it < 1024; it += gridDim.x) gdn_pre(p, it, smem);
  for (int it = blockIdx.x; it < 1024; it += gridDim.x) mlstm_pre(p, it, smem);
  xcd_barrier(xb);
  if (LAST_PHASE < 3) return;

  for (int it = blockIdx.x; it < 256 + 64; it += gridDim.x) {
    if (it < 128) gdn_scan(p, it & 15, it >> 4, smem);
    else if (it < 256) mlstm_scan(p, it & 15, (it - 128) >> 4, smem);
    else {
      bf16_t* Kb = (bf16_t*)(ws + OFF_KB);
      bf16_t* VT = (bf16_t*)(ws + OFF_VT);
      const int t2 = it - 256;
      const int mt = t2 >> 4, nt = t2 & 15;
      gemm256((const bf16_t*)(ws + OFF_MEMN), 1024, (const bf16_t*)(ws + OFF_WKVT), 1024, 1024, mt * 256, nt * 128, sA,
              (bf16_t*)(smem + 36864), [&](int m, int n, float v) {
                if (n < 1024) Kb[(size_t)m * 1024 + n] = f2bf(v);
                else {
                  const int d = (n - 1024) & 255, hh = (n - 1024) >> 8, bb = m >> 8, j = m & 255;
                  VT[(size_t)((bb * 4 + hh) * 256 + d) * 256 + j] = f2bf(v);
                }
              });
    }
  }
  xcd_barrier(xb);
  if (LAST_PHASE < 4) return;

  gate_phase(p);
  xcd_barrier(xb);

  {
    const float* x = p.x;
    float* out = p.out;
    for (int tile = blockIdx.x; tile < 64 * 8; tile += gridDim.x) {
      const int mt = (tile & 7) * 8 + (tile >> 6), nt = (tile >> 3) & 7;
      gemm256((const bf16_t*)(ws + OFF_MX), 1024, (const bf16_t*)(ws + OFF_WOUTT), 1024, 1024, mt * 256, nt * 128, sA, (bf16_t*)(smem + 36864),
              [&](int m, int n, float v) { out[(size_t)m * 1024 + n] = x[(size_t)m * 1024 + n] + v; });
    }
  }
  xcd_barrier(xb);
  if (LAST_PHASE < 6) return;

  rmsnorm_rows(p.out, p.norm_xa_w, (bf16_t*)(ws + OFF_H2), T_TOK);
  xcd_barrier(xb);

  const bool conv_first = blockIdx.x >= (gridDim.x >> 1);
  if (conv_first) convert_rows_fp8(p.peer_u, (unsigned char*)(ws + OFF_UB), (float*)(ws + OFF_USC), 16384);
  {
    bf16_t* Qx = (bf16_t*)(ws + OFF_QX);
    for (int tile = blockIdx.x; tile < 64 * 8; tile += gridDim.x) {
      const int mt = (tile & 7) * 8 + (tile >> 6), nt = (tile >> 3) & 7;
      gemm256((const bf16_t*)(ws + OFF_H2), 1024, (const bf16_t*)(ws + OFF_WQT), 1024, 1024, mt * 256, nt * 128, sA, (bf16_t*)(smem + 36864),
              [&](int m, int n, float v) { Qx[(size_t)m * 1024 + n] = f2bf(v); });
    }
  }
  if (!conv_first) convert_rows_fp8(p.peer_u, (unsigned char*)(ws + OFF_UB), (float*)(ws + OFF_USC), 16384);
  xcd_barrier(xb);

  if (conv_first) convert_rows_fp8(p.peer_v, (unsigned char*)(ws + OFF_VB), (float*)(ws + OFF_VSC), 16384);
  for (int it = blockIdx.x; it < 512; it += gridDim.x) {
    const int r = it >> 3;
    attn_item(p, ((it & 7) * 2 + (r >> 5)) * 32 + (r & 31), smem);
  }
  if (!conv_first) convert_rows_fp8(p.peer_v, (unsigned char*)(ws + OFF_VB), (float*)(ws + OFF_VSC), 16384);
  xcd_barrier(xb);

  {
    float* out = p.out;
    for (int tile = blockIdx.x; tile < 64 * 8; tile += gridDim.x) {
      const int mt = (tile & 7) * 8 + (tile >> 6), nt = (tile >> 3) & 7;
      gemm256((const bf16_t*)(ws + OFF_AO), 1024, (const bf16_t*)(ws + OFF_WOT), 1024, 1024, mt * 256, nt * 128, sA, (bf16_t*)(smem + 36864),
              [&](int m, int n, float v) { out[(size_t)m * 1024 + n] += v; });
    }
  }
  xcd_barrier(xb);
  if (LAST_PHASE < 10) return;

  rmsnorm_rows(p.out, p.norm_ffn_w, (bf16_t*)(ws + OFF_H3), T_TOK);
  xcd_barrier(xb);

  for (int it = blockIdx.x; it < 1024; it += gridDim.x) {
    const int mt = (it >> 9) * 64 + (it & 7) * 8 + ((it >> 6) & 7), hh = (it >> 3) & 7;
    peer_route_item(p, mt * 8 + hh, smem);
  }
  xcd_barrier(xb);

  peer_u_phase(p);
  xcd_barrier(xb);
  peer_w_phase(p);
  xcd_barrier(xb);
  peer_v_phase(p);
  xcd_barrier(xb);
  final_norm_phase(p);
}

extern "C" void kernel_launch(void* const* d_in, const int* in_sizes, int n_in, void* d_out, int out_size, void* d_ws,
                              size_t ws_size, hipStream_t stream) {
  static int grid_blocks = 0;
  if (!grid_blocks) {
    int dev = 0, cus = 0, per_cu = 0;
    hipGetDevice(&dev);
    hipDeviceGetAttribute(&cus, hipDeviceAttributeMultiprocessorCount, dev);
    hipOccupancyMaxActiveBlocksPerMultiprocessor(&per_cu, hymba_mega, 256, 0);
    if (per_cu > 2) per_cu = 2;
    grid_blocks = cus * per_cu;
  }
  if (ws_size < OFF_END) { fprintf(stderr, "workspace too small\n"); return; }
  Params p{};
  const float** pp = (const float**)&p;
  for (int i = 0; i < 24; ++i) pp[i] = (const float*)d_in[i];
  p.out = (float*)d_out;
  p.ws = (char*)d_ws;
  void* args[] = {&p};
  (void)hipMemsetAsync((char*)d_ws + OFF_BAR, 0, 16384, stream);
  hipError_t e = hipLaunchCooperativeKernel((void*)hymba_mega, dim3(grid_blocks), dim3(256), args, 0, stream);
  if (e != hipSuccess) fprintf(stderr, "cooperative launch failed: %s (grid %d)\n", hipGetErrorString(e), grid_blocks);
}
```

```cpp
#include <hip/hip_runtime.h>
#include <hip/hip_cooperative_groups.h>
#include <cstdio>
namespace cg = cooperative_groups;

typedef unsigned short bf16_t;
using bf16x8 = __attribute__((ext_vector_type(8))) short;
using f32x4 = __attribute__((ext_vector_type(4))) float;
using f32x16 = __attribute__((ext_vector_type(16))) float;
using u32x4 = __attribute__((ext_vector_type(4))) unsigned;

#define DI __device__ __forceinline__
#define MFMA32(a, b, c) __builtin_amdgcn_mfma_f32_32x32x16_bf16((a), (b), (c), 0, 0, 0)
#define MFMA16(a, b, c) __builtin_amdgcn_mfma_f32_16x16x32_bf16((a), (b), (c), 0, 0, 0)

static constexpr int T_TOK = 16384;
static constexpr size_t MiB = 1024 * 1024;
static constexpr size_t OFF_P = 0;
static constexpr size_t OFF_R1 = 128 * MiB;
static constexpr size_t OFF_R2 = 200 * MiB;
static constexpr size_t OFF_WINT = OFF_R2;
static constexpr size_t OFF_WOUTT = OFF_WINT + 4224 * 1024 * 2;
static constexpr size_t OFF_WQT = OFF_WOUTT + 2 * MiB;
static constexpr size_t OFF_WKVT = OFF_WQT + 2 * MiB;
static constexpr size_t OFF_WOT = OFF_WKVT + 4 * MiB;
static constexpr size_t OFF_PWQT = OFF_WOT + 2 * MiB;
static constexpr size_t OFF_SKB = OFF_PWQT + 4 * MiB;
static constexpr size_t OFF_G = OFF_SKB + MiB / 2;
static constexpr size_t OFF_MEMN = OFF_G + 1 * MiB;
static constexpr size_t OFF_KB = OFF_MEMN + 2 * MiB;
static constexpr size_t OFF_VT = OFF_KB + 2 * MiB;
static constexpr size_t OFF_GLAST = OFF_VT + 2 * MiB;
static constexpr size_t OFF_MSMALL = OFF_GLAST + 4096;
static constexpr size_t OFF_BAR = OFF_MSMALL + 2 * MiB;
static constexpr size_t OFF_END = OFF_BAR + 16384;
static constexpr size_t OFF_H2 = 0;
static constexpr size_t OFF_QX = 32 * MiB;
static constexpr size_t OFF_AO = 64 * MiB;
static constexpr size_t OFF_H3 = 96 * MiB;
static constexpr size_t OFF_EID = 0;
static constexpr size_t OFF_GATE = 8 * MiB;
static constexpr size_t OFF_PART = 16 * MiB;
static constexpr size_t OFF_W = 80 * MiB;
static constexpr size_t OFF_SSP = 88 * MiB;
static constexpr size_t OFF_MX = OFF_R1;
static constexpr size_t OFF_UB = OFF_R1;
static constexpr size_t OFF_VB = OFF_R1 + 16 * MiB;
static constexpr size_t OFF_USC = OFF_R1 + 64 * MiB;
static constexpr size_t OFF_VSC = OFF_USC + 65536;

static constexpr int GDN_INT_BYTES = 73728;
static constexpr int ML_INT_BYTES = 57344;
static constexpr int SMEM_BYTES = 77824;

struct Params {
  const float *x, *mem, *norm_mix_w, *w_in, *gdn_conv_w, *gdn_a_log, *gdn_dt_bias, *gdn_norm_w, *mlstm_conv_w,
      *mlstm_i_bias, *mlstm_f_bias, *mlstm_norm_w, *w_out, *norm_xa_w, *norm_mem_w, *xa_wq, *xa_wkv, *xa_wo,
      *norm_ffn_w, *peer_wq, *peer_sub_keys, *peer_u, *peer_v, *norm_final_w;
  float* out;
  char* ws;
};

typedef float f32x2 __attribute__((ext_vector_type(2)));
typedef __bf16 bf16x2_t __attribute__((ext_vector_type(2)));
DI unsigned pk2(float a, float b) {
  f32x2 v = {a, b};
  bf16x2_t r = __builtin_convertvector(v, bf16x2_t);
  return __builtin_bit_cast(unsigned, r);
}
DI bf16_t f2bf(float f) { return (bf16_t)(pk2(f, 0.f) & 0xffffu); }
DI float bf2f(bf16_t h) { return __uint_as_float(((unsigned)h) << 16); }
DI float bflo(unsigned u) { return __uint_as_float(u << 16); }
DI float bfhi(unsigned u) { return __uint_as_float(u & 0xffff0000u); }
DI void unpack8(const uint4& v, float* f) {
  f[0] = bflo(v.x); f[1] = bfhi(v.x); f[2] = bflo(v.y); f[3] = bfhi(v.y);
  f[4] = bflo(v.z); f[5] = bfhi(v.z); f[6] = bflo(v.w); f[7] = bfhi(v.w);
}
DI uint4 pack8(const float* f) {
  uint4 v; v.x = pk2(f[0], f[1]); v.y = pk2(f[2], f[3]); v.z = pk2(f[4], f[5]); v.w = pk2(f[6], f[7]);
  return v;
}
DI float wave_sum(float v) {
#pragma unroll
  for (int o = 32; o >= 1; o >>= 1) v += __shfl_xor(v, o);
  return v;
}
DI float sigmoidf_(float x) { return __builtin_amdgcn_rcpf(1.f + __expf(-x)); }
DI float softplusf_(float x) { return fmaxf(x, 0.f) + __logf(1.f + __expf(-fabsf(x))); }
DI float logsigf_(float x) { return fminf(x, 0.f) - __logf(1.f + __expf(-fabsf(x))); }
DI int otid() { int t = threadIdx.x; asm volatile("" : "+v"(t)); return t; }
DI int fragoff(int row, int k, int KS) { return (((row >> 4) * KS + (k >> 5)) << 9) + (((((k >> 3) & 3) << 4) + (row & 15)) << 3) + (k & 7); }
DI int crow32(int r, int half) { return (r & 3) + 8 * (r >> 2) + 4 * half; }


#define XB_TMO      128
#define XB_XCNT(j)  (256  + 64 * (j))
#define XB_XSUB(j)  (1280 + 64 * (j))
#define XB_XGEN(j)  (2304 + 64 * (j))
#define XB_TOP      3328
#define XB_TOPGEN   3392
#define XCD_BAR_WORDS 3456
#define XB_SPIN_CAP (1u << 18)
#define LAS __attribute__((address_space(3)))
DI unsigned xb_ld(unsigned* p) { return __hip_atomic_load(p, __ATOMIC_RELAXED, __HIP_MEMORY_SCOPE_AGENT); }
DI unsigned xb_add(unsigned* p, unsigned v) { return __hip_atomic_fetch_add(p, v, __ATOMIC_RELAXED, __HIP_MEMORY_SCOPE_AGENT); }
DI unsigned xb_xcc_id() { return (unsigned)__builtin_amdgcn_s_getreg((3 << 11) | 20) & 0xFu; }
#define XB_SPIN(cond, bar) do { unsigned _sp = 0; while (cond) { __builtin_amdgcn_s_sleep(1); \
    if ((++_sp & 255u) == 0u) { if (xb_ld(&(bar)[XB_TMO])) break; if (_sp > XB_SPIN_CAP) { atomicAdd(&(bar)[XB_TMO], 1u); break; } } } } while (0)
struct XcdBarrier { unsigned* bar; unsigned x; volatile LAS unsigned* st; };
DI XcdBarrier xcd_barrier_post(unsigned* bar, volatile LAS unsigned* st) {
  XcdBarrier b; b.bar = bar; b.x = xb_xcc_id(); b.st = st;
  if (threadIdx.x == 0) (void)xb_add(&bar[XB_XCNT(b.x)], 1u);
  return b;
}
DI void xcd_barrier_complete(unsigned* bar, unsigned x, unsigned& nloc, unsigned& nx) {
  const unsigned G = gridDim.x * gridDim.y * gridDim.z;
  unsigned sum, cnt, mine, sp = 0u;
  for (;;) {
    sum = 0u; cnt = 0u; mine = 0u;
#pragma unroll
    for (unsigned j = 0; j < 16; ++j) { const unsigned c = xb_ld(&bar[XB_XCNT(j)]); sum += c; cnt += (c > 0u) ? 1u : 0u; mine = (j == x) ? c : mine; }
    if (sum == G) break;
    __builtin_amdgcn_s_sleep(1);
    if ((++sp & 255u) == 0u) { if (xb_ld(&bar[XB_TMO])) break; if (sp > XB_SPIN_CAP) { atomicAdd(&bar[XB_TMO], 1u); break; } }
  }
  nloc = mine > 0u ? mine : 1u; nx = cnt > 0u ? cnt : 1u;
}
DI void xcd_barrier(const XcdBarrier& b) {
  asm volatile("s_waitcnt vmcnt(0)" ::: "memory");
  __syncthreads();
  if (threadIdx.x == 0) {
    unsigned* bar = b.bar;
    __builtin_amdgcn_s_waitcnt(0);
    unsigned nloc = b.st[0], nx = b.st[1];
    if (nloc == 0u) { xcd_barrier_complete(bar, b.x, nloc, nx); b.st[0] = nloc; b.st[1] = nx; }
    const unsigned old = xb_add(&bar[XB_XSUB(b.x)], 1u);
    const unsigned gen = old / nloc;
    if (old + 1u == (gen + 1u) * nloc) {
      __builtin_amdgcn_fence(__ATOMIC_RELEASE, "agent");
      asm volatile("s_waitcnt vmcnt(0)" ::: "memory");
      const unsigned og = xb_add(&bar[XB_TOP], 1u);
      const unsigned tg = og / nx;
      if (og + 1u == (tg + 1u) * nx) xb_add(&bar[XB_TOPGEN], 1u);
      else XB_SPIN(xb_ld(&bar[XB_TOPGEN]) == tg, bar);
      __builtin_amdgcn_fence(__ATOMIC_ACQUIRE, "agent");
      xb_add(&bar[XB_XGEN(b.x)], 1u);
      asm volatile("s_waitcnt vmcnt(0)" ::: "memory");
    } else {
      XB_SPIN(xb_ld(&bar[XB_XGEN(b.x)]) == gen, bar);
      __builtin_amdgcn_fence(__ATOMIC_ACQUIRE, "agent");
      asm volatile("s_waitcnt vmcnt(0)" ::: "memory");
    }
  }
  __syncthreads();
}

DI int winmap(int np) {
  if (np < 2048) return np;
  if (np < 4096) return np + 8;
  int j = np - 4096;
  return j < 8 ? 2048 + j : 4104 + (j - 8);
}
DI void transpose_tile(const float* __restrict__ W, int K, int N, bf16_t* __restrict__ Wt, int Np, int kt, int nt,
                       int mode, float* sm) {
  const int tid = otid();
  const int tx = tid & 63, ty = tid >> 6;
#pragma unroll 4
  for (int i = 0; i < 16; ++i) {
    int k = ty + 4 * i;
    int np = nt * 64 + tx;
    float v = 0.f;
    if (np < Np) {
      int n = mode ? winmap(np) : np;
      v = W[(size_t)(kt * 64 + k) * N + n];
    }
    sm[k * 65 + tx] = v;
  }
  __syncthreads();
#pragma unroll 4
  for (int i = 0; i < 16; ++i) {
    int n = ty + 4 * i;
    int np = nt * 64 + n;
    if (np < Np) Wt[(size_t)np * K + kt * 64 + tx] = f2bf(sm[tx * 65 + n]);
  }
  __syncthreads();
}
DI void transpose_all(const float* W, int K, int N, bf16_t* Wt, int Np, int mode, float* sm) {
  const int ntn = (Np + 63) / 64, ntk = K / 64;
  for (int t = blockIdx.x; t < ntn * ntk; t += gridDim.x) transpose_tile(W, K, N, Wt, Np, t / ntn, t % ntn, mode, sm);
}
DI void rmsnorm_row(const float* __restrict__ src, const float* __restrict__ w, bf16_t* __restrict__ dst, int lane) {
  float4 v[4];
  float ss = 0.f;
#pragma unroll
  for (int j = 0; j < 4; ++j) {
    v[j] = ((const float4*)src)[lane + 64 * j];
    ss += v[j].x * v[j].x + v[j].y * v[j].y + v[j].z * v[j].z + v[j].w * v[j].w;
  }
  ss = wave_sum(ss);
  const float r = rsqrtf(ss * (1.f / 1024.f) + 1e-6f);
#pragma unroll
  for (int j = 0; j < 4; ++j) {
    float4 ww = ((const float4*)w)[lane + 64 * j];
    uint2 o;
    o.x = pk2(v[j].x * r * ww.x, v[j].y * r * ww.y);
    o.y = pk2(v[j].z * r * ww.z, v[j].w * r * ww.w);
    ((uint2*)dst)[lane + 64 * j] = o;
  }
}
DI void rmsnorm_rows(const float* src, const float* w, bf16_t* dst, int nrows) {
  const int tid_ = otid(); const int lane = tid_ & 63, wave = tid_ >> 6;
  for (int r = blockIdx.x * 4 + wave; r < nrows; r += gridDim.x * 4)
    rmsnorm_row(src + (size_t)r * 1024, w, dst + (size_t)r * 1024, lane);
}
DI void convert_f32_bf16(const float* src, bf16_t* dst, size_t n4) {
  for (size_t i = (size_t)blockIdx.x * 256 + threadIdx.x; i < n4; i += (size_t)gridDim.x * 256) {
    float4 v = ((const float4*)src)[i];
    uint2 o; o.x = pk2(v.x, v.y); o.y = pk2(v.z, v.w);
    ((uint2*)dst)[i] = o;
  }
}

static constexpr int LDS_ROW = 72;
template <class Epi>
DI void gemm128(const bf16_t* __restrict__ A, int lda, const bf16_t* __restrict__ B, int ldb, int K, int m0, int n0,
                bf16_t* sA, bf16_t* sB, Epi epi) {
  const int tid = otid(), lane = tid & 63, wave = tid >> 6;
  const int wm = wave >> 1, wn = wave & 1;
  const int lr = tid >> 3, lc = (tid & 7) * 8;
  f32x16 acc[2][2];
#pragma unroll
  for (int i = 0; i < 2; ++i)
#pragma unroll
    for (int j = 0; j < 2; ++j)
#pragma unroll
      for (int r = 0; r < 16; ++r) acc[i][j][r] = 0.f;
  u32x4 ra0, ra1, ra2, ra3, rb0, rb1, rb2, rb3;
  const bf16_t* Ap = A + (size_t)(m0 + lr) * lda + lc;
  const bf16_t* Bp = B + (size_t)(n0 + lr) * ldb + lc;
  ra0 = *(const u32x4*)(Ap); ra1 = *(const u32x4*)(Ap + (size_t)32 * lda);
  ra2 = *(const u32x4*)(Ap + (size_t)64 * lda); ra3 = *(const u32x4*)(Ap + (size_t)96 * lda);
  rb0 = *(const u32x4*)(Bp); rb1 = *(const u32x4*)(Bp + (size_t)32 * ldb);
  rb2 = *(const u32x4*)(Bp + (size_t)64 * ldb); rb3 = *(const u32x4*)(Bp + (size_t)96 * ldb);
  const int nk = K >> 6;
  for (int kt = 0; kt < nk; ++kt) {
    __syncthreads();
    *(u32x4*)(sA + (lr) * LDS_ROW + lc) = ra0; *(u32x4*)(sA + (lr + 32) * LDS_ROW + lc) = ra1;
    *(u32x4*)(sA + (lr + 64) * LDS_ROW + lc) = ra2; *(u32x4*)(sA + (lr + 96) * LDS_ROW + lc) = ra3;
    *(u32x4*)(sB + (lr) * LDS_ROW + lc) = rb0; *(u32x4*)(sB + (lr + 32) * LDS_ROW + lc) = rb1;
    *(u32x4*)(sB + (lr + 64) * LDS_ROW + lc) = rb2; *(u32x4*)(sB + (lr + 96) * LDS_ROW + lc) = rb3;
    __syncthreads();
    if (kt + 1 < nk) {
      const int ko2 = (kt + 1) * 64;
      ra0 = *(const u32x4*)(Ap + ko2); ra1 = *(const u32x4*)(Ap + (size_t)32 * lda + ko2);
      ra2 = *(const u32x4*)(Ap + (size_t)64 * lda + ko2); ra3 = *(const u32x4*)(Ap + (size_t)96 * lda + ko2);
      rb0 = *(const u32x4*)(Bp + ko2); rb1 = *(const u32x4*)(Bp + (size_t)32 * ldb + ko2);
      rb2 = *(const u32x4*)(Bp + (size_t)64 * ldb + ko2); rb3 = *(const u32x4*)(Bp + (size_t)96 * ldb + ko2);
    }
#pragma unroll
    for (int s = 0; s < 4; ++s) {
      const int ko = s * 16 + (lane >> 5) * 8;
      bf16x8 a0 = *(const bf16x8*)(sA + (wm * 64 + (lane & 31)) * LDS_ROW + ko);
      bf16x8 a1 = *(const bf16x8*)(sA + (wm * 64 + 32 + (lane & 31)) * LDS_ROW + ko);
      bf16x8 b0 = *(const bf16x8*)(sB + (wn * 64 + (lane & 31)) * LDS_ROW + ko);
      bf16x8 b1 = *(const bf16x8*)(sB + (wn * 64 + 32 + (lane & 31)) * LDS_ROW + ko);
      acc[0][0] = MFMA32(a0, b0, acc[0][0]);
      acc[0][1] = MFMA32(a0, b1, acc[0][1]);
      acc[1][0] = MFMA32(a1, b0, acc[1][0]);
      acc[1][1] = MFMA32(a1, b1, acc[1][1]);
    }
  }
#pragma unroll
  for (int i = 0; i < 2; ++i)
#pragma unroll
    for (int j = 0; j < 2; ++j)
#pragma unroll
      for (int r = 0; r < 16; ++r) {
        const int m = m0 + wm * 64 + i * 32 + crow32(r, lane >> 5);
        const int n = n0 + wn * 64 + j * 32 + (lane & 31);
        epi(m, n, acc[i][j][r]);
      }
}

template <class Epi>
DI void gemm256(const bf16_t* __restrict__ A, int lda, const bf16_t* __restrict__ B, int ldb, int K, int m0, int n0,
                bf16_t* sA, bf16_t* sB, Epi epi) {
  const int tid = otid(), lane = tid & 63, wave = tid >> 6;
  const int wm = wave >> 1, wn = wave & 1;
  const int lr = tid >> 3, lc = (tid & 7) * 8;
  f32x16 acc[4][2];
#pragma unroll
  for (int i = 0; i < 4; ++i)
#pragma unroll
    for (int j = 0; j < 2; ++j)
#pragma unroll
      for (int r = 0; r < 16; ++r) acc[i][j][r] = 0.f;
  u32x4 ra0, ra1, ra2, ra3, ra4, ra5, ra6, ra7, rb0, rb1, rb2, rb3;
  const bf16_t* Ap = A + (size_t)(m0 + lr) * lda + lc;
  const bf16_t* Bp = B + (size_t)(n0 + lr) * ldb + lc;
#define G256_LOAD(ko)                                                                             \
  ra0 = *(const u32x4*)(Ap + (ko)); ra1 = *(const u32x4*)(Ap + (size_t)32 * lda + (ko));          \
  ra2 = *(const u32x4*)(Ap + (size_t)64 * lda + (ko)); ra3 = *(const u32x4*)(Ap + (size_t)96 * lda + (ko));   \
  ra4 = *(const u32x4*)(Ap + (size_t)128 * lda + (ko)); ra5 = *(const u32x4*)(Ap + (size_t)160 * lda + (ko)); \
  ra6 = *(const u32x4*)(Ap + (size_t)192 * lda + (ko)); ra7 = *(const u32x4*)(Ap + (size_t)224 * lda + (ko)); \
  rb0 = *(const u32x4*)(Bp + (ko)); rb1 = *(const u32x4*)(Bp + (size_t)32 * ldb + (ko));          \
  rb2 = *(const u32x4*)(Bp + (size_t)64 * ldb + (ko)); rb3 = *(const u32x4*)(Bp + (size_t)96 * ldb + (ko));
  G256_LOAD(0)
  const int nk = K >> 6;
  for (int kt = 0; kt < nk; ++kt) {
    __syncthreads();
    *(u32x4*)(sA + (lr) * LDS_ROW + lc) = ra0; *(u32x4*)(sA + (lr + 32) * LDS_ROW + lc) = ra1;
    *(u32x4*)(sA + (lr + 64) * LDS_ROW + lc) = ra2; *(u32x4*)(sA + (lr + 96) * LDS_ROW + lc) = ra3;
    *(u32x4*)(sA + (lr + 128) * LDS_ROW + lc) = ra4; *(u32x4*)(sA + (lr + 160) * LDS_ROW + lc) = ra5;
    *(u32x4*)(sA + (lr + 192) * LDS_ROW + lc) = ra6; *(u32x4*)(sA + (lr + 224) * LDS_ROW + lc) = ra7;
    *(u32x4*)(sB + (lr) * LDS_ROW + lc) = rb0; *(u32x4*)(sB + (lr + 32) * LDS_ROW + lc) = rb1;
    *(u32x4*)(sB + (lr + 64) * LDS_ROW + lc) = rb2; *(u32x4*)(sB + (lr + 96) * LDS_ROW + lc) = rb3;
    __syncthreads();
    if (kt + 1 < nk) {
      const int ko2 = (kt + 1) * 64;
      G256_LOAD(ko2)
    }
#pragma unroll
    for (int s = 0; s < 4; ++s) {
      const int ko = s * 16 + (lane >> 5) * 8;
      bf16x8 b0 = *(const bf16x8*)(sB + (wn * 64 + (lane & 31)) * LDS_ROW + ko);
      bf16x8 b1 = *(const bf16x8*)(sB + (wn * 64 + 32 + (lane & 31)) * LDS_ROW + ko);
#pragma unroll
      for (int i = 0; i < 4; ++i) {
        bf16x8 a = *(const bf16x8*)(sA + (wm * 128 + i * 32 + (lane & 31)) * LDS_ROW + ko);
        acc[i][0] = MFMA32(a, b0, acc[i][0]);
        acc[i][1] = MFMA32(a, b1, acc[i][1]);
      }
    }
  }
#undef G256_LOAD
#pragma unroll
  for (int i = 0; i < 4; ++i)
#pragma unroll
    for (int j = 0; j < 2; ++j)
#pragma unroll
      for (int r = 0; r < 16; ++r) {
        const int m = m0 + wm * 128 + i * 32 + crow32(r, lane >> 5);
        const int n = n0 + wn * 64 + j * 32 + (lane & 31);
        epi(m, n, acc[i][j][r]);
      }
}

DI void conv32(const bf16_t* __restrict__ Pcol, int tok, int spos, const float* wl, int wstride, float* acc) {
#pragma unroll
  for (int hq = 0; hq < 2; ++hq) {
    __builtin_amdgcn_sched_barrier(0);
    uint4 v[4][2];
#pragma unroll
    for (int j = 0; j < 4; ++j) {
      const bool ok = (spos - 3 + j >= 0);
      const uint4* src = (const uint4*)(Pcol + (size_t)(tok - 3 + (ok ? j : 3)) * 4096) + 2 * hq;
#pragma unroll
      for (int q = 0; q < 2; ++q) {
        v[j][q] = src[q];
        if (!ok) v[j][q] = make_uint4(0u, 0u, 0u, 0u);
      }
    }
#pragma unroll
    for (int i = 0; i < 16; ++i) acc[16 * hq + i] = 0.f;
#pragma unroll
    for (int j = 0; j < 4; ++j) {
      const float4* w4 = (const float4*)(wl + j * wstride + 16 * hq);
#pragma unroll
      for (int q = 0; q < 2; ++q) {
        float f[8];
        unpack8(v[j][q], f);
        float4 wa = w4[2 * q], wb = w4[2 * q + 1];
        float* a = acc + 16 * hq + 8 * q;
        a[0] += wa.x * f[0]; a[1] += wa.y * f[1]; a[2] += wa.z * f[2]; a[3] += wa.w * f[3];
        a[4] += wb.x * f[4]; a[5] += wb.y * f[5]; a[6] += wb.z * f[6]; a[7] += wb.w * f[7];
      }
    }
#pragma unroll
    for (int i = 0; i < 16; ++i) acc[16 * hq + i] = acc[16 * hq + i] * sigmoidf_(acc[16 * hq + i]);
  }
  __builtin_amdgcn_sched_barrier(0);
}

DI void gdn_pre(const Params& p, int ch, char* smem) {
  const int tid = otid(), lane = tid & 63, wave = tid >> 6;
  const int b = ch >> 8, h = (ch >> 6) & 3, c = ch & 63;
  const int tok0 = b * 4096 + c * 64;
  bf16_t* qh = (bf16_t*)smem;
  bf16_t* kh = qh + 64 * 136;
  float* X = (float*)smem;
  float* Amat = (float*)(smem + 34816);
  float* s_la = (float*)(smem + 34816 + 16384);
  float* s_beta = s_la + 64;
  float* s_gc = s_beta + 64;
  float* s_eg = s_gc + 64;
  float* s_w = (float*)(smem + 52224);
  const bf16_t* P = (const bf16_t*)(p.ws + OFF_P);
  const float* G = (const float*)(p.ws + OFF_G);
  char* gi = p.ws + OFF_R1 + (size_t)ch * GDN_INT_BYTES;
  for (int i = tid; i < 1536; i += 256) {
    const int j = i / 384, r = i % 384;
    s_w[i] = p.gdn_conv_w[j * 1536 + (r >> 7) * 512 + h * 128 + (r & 127)];
  }
  bf16_t* o_w = (bf16_t*)gi;
  bf16_t* o_qd = (bf16_t*)(gi + 16384);
  bf16_t* o_kdT = (bf16_t*)(gi + 32768);
  bf16_t* o_uT = (bf16_t*)(gi + 49152);
  bf16_t* o_qk = (bf16_t*)(gi + 65536);

  if (tid < 64) {
    float ga = G[(size_t)h * T_TOK + tok0 + tid], gb = G[(size_t)(4 + h) * T_TOK + tok0 + tid];
    float sp = softplusf_(ga + p.gdn_dt_bias[h]);
    float s = -__expf(p.gdn_a_log[h]) * sp;
    s_beta[tid] = sigmoidf_(gb);
#pragma unroll
    for (int d = 1; d < 64; d <<= 1) {
      const float o = __shfl_up(s, d);
      if (lane >= d) s += o;
    }
    s_gc[tid] = s;
    s_eg[tid] = __expf(s);
  }
  __syncthreads();
  const int t = tid >> 2, part = tid & 3;
  const float gct = s_gc[t], bet = s_beta[t], egt = s_eg[t], gcl = s_gc[63];
  float kk[32], vv[32];
  {
    float a[32];
    conv32(P + h * 128 + part * 32, tok0 + t, c * 64 + t, s_w + part * 32, 384, a);
    float ss = 0.f;
#pragma unroll
    for (int i = 0; i < 32; ++i) ss += a[i] * a[i];
    ss += __shfl_xor(ss, 1);
    ss += __shfl_xor(ss, 2);
    float rn = rsqrtf(ss + 1e-6f) * 0.08838834764831845f;
#pragma unroll
    for (int i = 0; i < 32; ++i) a[i] *= rn;
#pragma unroll
    for (int q = 0; q < 4; ++q) *(uint4*)(qh + t * 136 + part * 32 + 8 * q) = pack8(a + 8 * q);
#pragma unroll
    for (int i = 0; i < 32; ++i) a[i] *= egt;
#pragma unroll
    for (int q = 0; q < 4; ++q) *(uint4*)(o_qd + fragoff(t, part * 32 + 8 * q, 4)) = pack8(a + 8 * q);
  }
  {
    conv32(P + 512 + h * 128 + part * 32, tok0 + t, c * 64 + t, s_w + 128 + part * 32, 384, kk);
    float ss = 0.f;
#pragma unroll
    for (int i = 0; i < 32; ++i) ss += kk[i] * kk[i];
    ss += __shfl_xor(ss, 1);
    ss += __shfl_xor(ss, 2);
    float rn = rsqrtf(ss + 1e-6f);
#pragma unroll
    for (int i = 0; i < 32; ++i) kk[i] *= rn;
#pragma unroll
    for (int q = 0; q < 4; ++q) *(uint4*)(kh + t * 136 + part * 32 + 8 * q) = pack8(kk + 8 * q);
    const float ek = __expf(gcl - gct);
#pragma unroll
    for (int i = 0; i < 32; ++i) o_kdT[fragoff(part * 32 + i, t, 2)] = f2bf(kk[i] * ek);
  }
  __syncthreads();
  {
    const int ti = wave >> 1, tj = wave & 1;
    f32x16 accA, accQ;
#pragma unroll
    for (int r = 0; r < 16; ++r) { accA[r] = 0.f; accQ[r] = 0.f; }
#pragma unroll
    for (int s = 0; s < 8; ++s) {
      const int ko = s * 16 + (lane >> 5) * 8;
      bf16x8 bk = *(const bf16x8*)(kh + (tj * 32 + (lane & 31)) * 136 + ko);
      bf16x8 ak = *(const bf16x8*)(kh + (ti * 32 + (lane & 31)) * 136 + ko);
      bf16x8 aq = *(const bf16x8*)(qh + (ti * 32 + (lane & 31)) * 136 + ko);
      accA = MFMA32(ak, bk, accA);
      accQ = MFMA32(aq, bk, accQ);
    }
    const int j = tj * 32 + (lane & 31);
    const float gcj = s_gc[j];
#pragma unroll
    for (int r = 0; r < 16; ++r) {
      const int i = ti * 32 + crow32(r, lane >> 5);
      const float dec = (i >= j) ? __expf(s_gc[i] - gcj) : 0.f;
      Amat[i * 64 + j] = (i > j) ? s_beta[i] * accA[r] * dec : 0.f;
      o_qk[fragoff(i, j, 2)] = f2bf(accQ[r] * dec);
    }
  }
  conv32(P + 1024 + h * 128 + part * 32, tok0 + t, c * 64 + t, s_w + 256 + part * 32, 384, vv);
  __syncthreads();
  f32x2 c2[32];
#pragma unroll
  for (int q = 0; q < 8; ++q) {
    float4 v4 = make_float4(vv[4 * q] * bet, vv[4 * q + 1] * bet, vv[4 * q + 2] * bet, vv[4 * q + 3] * bet);
    *(float4*)(X + t * 132 + part * 32 + 4 * q) = v4;
  }
  __syncthreads();
  if (tid < 128) {
#pragma unroll
    for (int tt = 0; tt < 64; ++tt) c2[tt >> 1][tt & 1] = X[tt * 132 + tid];
  }
  __syncthreads();
  {
    const float f = bet * egt;
#pragma unroll
    for (int q = 0; q < 8; ++q) {
      float4 v4 = make_float4(kk[4 * q] * f, kk[4 * q + 1] * f, kk[4 * q + 2] * f, kk[4 * q + 3] * f);
      *(float4*)(X + t * 132 + part * 32 + 4 * q) = v4;
    }
  }
  __syncthreads();
  if (tid >= 128) {
#pragma unroll
    for (int tt = 0; tt < 64; ++tt) c2[tt >> 1][tt & 1] = X[tt * 132 + tid - 128];
  }
#pragma unroll
  for (int i = 1; i < 64; ++i) {
    f32x2 sa = {0.f, 0.f}, sb = {0.f, 0.f};
    const f32x2* arow = (const f32x2*)(Amat + i * 64);
#pragma unroll
    for (int k = 0; k < (i >> 1); ++k) {
      const f32x2 a2 = arow[k];
      if (k & 1) sb = __builtin_elementwise_fma(a2, c2[k], sb);
      else sa = __builtin_elementwise_fma(a2, c2[k], sa);
    }
    float tot = (sa[0] + sa[1]) + (sb[0] + sb[1]);
    if (i & 1) tot += Amat[i * 64 + i - 1] * c2[(i - 1) >> 1][0];
    c2[i >> 1][i & 1] -= tot;
    __builtin_amdgcn_sched_barrier(0);
  }
  if (tid < 128) {
#pragma unroll
    for (int q = 0; q < 16; ++q) {
      const int l = 4 * q;
      uint2 v2; v2.x = pk2(c2[2 * q][0], c2[2 * q][1]); v2.y = pk2(c2[2 * q + 1][0], c2[2 * q + 1][1]);
      *(uint2*)(o_uT + ((((tid >> 4) * 4 + (l >> 4)) * 64 + ((l >> 2) & 3) * 16 + (tid & 15)) << 2)) = v2;
    }
  } else {
    const int cc = tid - 128;
#pragma unroll
    for (int tt = 0; tt < 64; ++tt) o_w[fragoff(tt, cc, 4)] = f2bf(c2[tt >> 1][tt & 1]);
  }
  if (tid == 0) ((float*)(p.ws + OFF_GLAST))[ch] = s_eg[63];
  __syncthreads();
}

DI void mlstm_pre(const Params& p, int ch, char* smem) {
  const int tid = otid(), lane = tid & 63, wave = tid >> 6;
  const int b = ch >> 8, h = (ch >> 6) & 3, c = ch & 63;
  const int tok0 = b * 4096 + c * 64;
  bf16_t* qs = (bf16_t*)smem;
  bf16_t* ks = qs + 64 * 136;
  float* sm = (float*)(smem + 34816);
  float* s_li = sm, *s_lf = sm + 64, *s_bc = sm + 128, *s_pm = sm + 192, *s_mt = sm + 256, *s_bl = sm + 320,
        *s_md = sm + 384, *s_rs = sm + 448, *s_kw = sm + 512, *s_misc = sm + 640;
  const bf16_t* P = (const bf16_t*)(p.ws + OFF_P);
  const float* G = (const float*)(p.ws + OFF_G);
  char* mi = (char*)p.out + (size_t)ch * ML_INT_BYTES;
  bf16_t* o_q = (bf16_t*)mi;
  bf16_t* o_kwT = (bf16_t*)(mi + 16384);
  bf16_t* o_vT = (bf16_t*)(mi + 32768);
  bf16_t* o_p = (bf16_t*)(mi + 49152);
  float* ms = (float*)(p.ws + OFF_MSMALL) + (size_t)ch * 512;
  const float ib = p.mlstm_i_bias[h], fb = p.mlstm_f_bias[h];

  float* s_w = (float*)(smem + 40960);
  for (int i = tid; i < 1024; i += 256) {
    const int j = i >> 8, r = i & 255;
    s_w[i] = p.mlstm_conv_w[j * 1024 + (r >> 7) * 512 + h * 128 + (r & 127)];
  }
  {
    const int j = tid >> 2, qd = tid & 3;
    float s = 0.f, mx = -INFINITY;
    if (j < c) {
      const float4* gi4 = (const float4*)(G + (size_t)(8 + h) * T_TOK + b * 4096 + j * 64 + qd * 16);
      const float4* gf4 = (const float4*)(G + (size_t)(12 + h) * T_TOK + b * 4096 + j * 64 + qd * 16);
      float xi[16], xf[16];
#pragma unroll
      for (int i = 0; i < 4; ++i) {
        const float4 a = gi4[i], f = gf4[i];
        xi[4 * i] = a.x; xi[4 * i + 1] = a.y; xi[4 * i + 2] = a.z; xi[4 * i + 3] = a.w;
        xf[4 * i] = f.x; xf[4 * i + 1] = f.y; xf[4 * i + 2] = f.z; xf[4 * i + 3] = f.w;
      }
#pragma unroll
      for (int i = 0; i < 16; ++i) { s += logsigf_(xf[i] + fb); mx = fmaxf(mx, xi[i] + ib - s); }
    }
    const int base = lane & ~3;
    float S = 0.f, M = -INFINITY;
#pragma unroll
    for (int k = 0; k < 4; ++k) {
      const float sk = __shfl(s, base + k), mk = __shfl(mx, base + k);
      M = fmaxf(M, mk - S);
      S += sk;
    }
    if (qd == 0) { s_bl[j] = S; s_md[j] = S + M; }
  }
  if (tid < 64) {
    const float li = G[(size_t)(8 + h) * T_TOK + tok0 + tid] + ib;
    const float lf = logsigf_(G[(size_t)(12 + h) * T_TOK + tok0 + tid] + fb);
    s_li[tid] = li;
    s_rs[tid] = 0.f;
    float s = lf;
#pragma unroll
    for (int d = 1; d < 64; d <<= 1) {
      const float o = __shfl_up(s, d);
      if (lane >= d) s += o;
    }
    float pm = li - s;
#pragma unroll
    for (int d = 1; d < 64; d <<= 1) {
      const float o = __shfl_up(pm, d);
      if (lane >= d) pm = fmaxf(pm, o);
    }
    s_bc[tid] = s;
    s_pm[tid] = pm;
  }
  if (tid < 128) s_kw[tid] = 0.f;
  __syncthreads();
  if (wave == 0) {
    float a = s_bl[lane], bb = s_md[lane];
#pragma unroll
    for (int d = 1; d < 64; d <<= 1) {
      const float a2 = __shfl_up(a, d), b2 = __shfl_up(bb, d);
      if (lane >= d) { bb = fmaxf(b2 + a, bb); a = a2 + a; }
    }
    if (lane == 63) s_misc[0] = fmaxf(a, bb);
  }
  __syncthreads();
  const float m = s_misc[0];
  const float b_last = s_bc[63];
  const float m_new = fmaxf(b_last + m, b_last + s_pm[63]);
  float fl_val = 0.f;
  float* s_sc = sm + 648;
  if (tid < 64) {
    const float mt = fmaxf(s_bc[tid] + m, s_bc[tid] + s_pm[tid]);
    s_mt[tid] = mt;
    s_sc[tid] = __expf(s_bc[tid] + m - mt);
    fl_val = __expf(-mt);
  }
  if (tid == 0) ms[384] = __expf(b_last + m - m_new);
  __syncthreads();
  const int t = tid >> 2, part = tid & 3;
  const float wgt = __expf(b_last - s_bc[t] + s_li[t] - m_new);
  {
    float a[32];
    conv32(P + 2048 + h * 128 + part * 32, tok0 + t, c * 64 + t, s_w + part * 32, 256, a);
#pragma unroll
    for (int q = 0; q < 4; ++q) *(uint4*)(qs + t * 136 + part * 32 + 8 * q) = pack8(a + 8 * q);
    {
      const float sct = s_sc[t];
#pragma unroll
      for (int i = 0; i < 32; ++i) a[i] *= sct;
#pragma unroll
      for (int q = 0; q < 4; ++q) *(uint4*)(o_q + fragoff(t, part * 32 + 8 * q, 4)) = pack8(a + 8 * q);
    }
    conv32(P + 2560 + h * 128 + part * 32, tok0 + t, c * 64 + t, s_w + 128 + part * 32, 256, a);
#pragma unroll
    for (int i = 0; i < 32; ++i) a[i] *= 0.08838834764831845f;
#pragma unroll
    for (int q = 0; q < 4; ++q) *(uint4*)(ks + t * 136 + part * 32 + 8 * q) = pack8(a + 8 * q);
#pragma unroll
    for (int i = 0; i < 32; ++i) {
      bf16_t kb = f2bf(a[i] * wgt);
      o_kwT[fragoff(part * 32 + i, t, 2)] = kb;
      atomicAdd(&s_kw[part * 32 + i], bf2f(kb));
    }
    const uint4* vsrc = (const uint4*)(P + (size_t)(tok0 + t) * 4096 + 3072 + h * 128 + part * 32);
#pragma unroll
    for (int q = 0; q < 4; ++q) {
      uint4 v = vsrc[q];
      const unsigned uu[4] = {v.x, v.y, v.z, v.w};
#pragma unroll
      for (int e = 0; e < 4; ++e) {
        o_vT[fragoff(part * 32 + 8 * q + 2 * e, t, 2)] = (bf16_t)(uu[e] & 0xffffu);
        o_vT[fragoff(part * 32 + 8 * q + 2 * e + 1, t, 2)] = (bf16_t)(uu[e] >> 16);
      }
    }
  }
  __syncthreads();
  {
    const int ti = wave >> 1, tj = wave & 1;
    f32x16 acc;
#pragma unroll
    for (int r = 0; r < 16; ++r) acc[r] = 0.f;
#pragma unroll
    for (int s = 0; s < 8; ++s) {
      const int ko = s * 16 + (lane >> 5) * 8;
      bf16x8 bk = *(const bf16x8*)(ks + (tj * 32 + (lane & 31)) * 136 + ko);
      bf16x8 aq = *(const bf16x8*)(qs + (ti * 32 + (lane & 31)) * 136 + ko);
      acc = MFMA32(aq, bk, acc);
    }
    const int j = tj * 32 + (lane & 31);
    const float cj = s_li[j] - s_bc[j];
#pragma unroll
    for (int r = 0; r < 16; ++r) {
      const int i = ti * 32 + crow32(r, lane >> 5);
      float pv = (i >= j) ? acc[r] * __expf(s_bc[i] + cj - s_mt[i]) : 0.f;
      o_p[fragoff(i, j, 2)] = f2bf(pv);
      pv += __shfl_xor(pv, 1);
      pv += __shfl_xor(pv, 2);
      pv += __shfl_xor(pv, 4);
      pv += __shfl_xor(pv, 8);
      pv += __shfl_xor(pv, 16);
      if ((lane & 31) == 0) atomicAdd(&s_rs[i], pv);
    }
  }
  __syncthreads();
  if (tid < 64) { ms[tid] = s_rs[tid]; ms[64 + tid] = fl_val; }
  if (tid < 128) ms[256 + tid] = s_kw[tid];
  __syncthreads();
}

DI uint2 pack4(float a, float b, float c, float d) { uint2 o; o.x = pk2(a, b); o.y = pk2(c, d); return o; }

DI void lds_barrier() { asm volatile("s_waitcnt lgkmcnt(0)\n\ts_barrier" ::: "memory"); }

struct GdnFrag {
  bf16x8 aW[4], aQ[4], aK[2], aD[2][2];
  uint2 uu;
  float gl;
};
DI void gdn_load(GdnFrag& f, const char* gi, const float* GL, int chidx, int slice, int wave, int l16, int kg) {
  const bf16_t* w = (const bf16_t*)gi;
  const bf16_t* qd = (const bf16_t*)(gi + 16384);
  const bf16_t* kdT = (const bf16_t*)(gi + 32768);
  const bf16_t* uT = (const bf16_t*)(gi + 49152);
  const bf16_t* qk = (const bf16_t*)(gi + 65536);
  const int ln = kg * 16 + l16;
#pragma unroll
  for (int s = 0; s < 4; ++s) {
    f.aW[s] = *(const bf16x8*)(w + (((wave * 4 + s) * 64 + ln) << 3));
    f.aQ[s] = *(const bf16x8*)(qd + (((wave * 4 + s) * 64 + ln) << 3));
  }
#pragma unroll
  for (int s = 0; s < 2; ++s) {
    f.aK[s] = *(const bf16x8*)(qk + (((wave * 2 + s) * 64 + ln) << 3));
#pragma unroll
    for (int tI = 0; tI < 2; ++tI) f.aD[tI][s] = *(const bf16x8*)(kdT + ((((2 * wave + tI) * 2 + s) * 64 + ln) << 3));
  }
  f.uu = *(const uint2*)(uT + (((slice * 4 + wave) * 64 + ln) << 2));
  f.gl = GL[chidx];
}

DI void gdn_scan(const Params& p, int seq, int slice, char* smem) {
  const int tid = otid(), lane = tid & 63, wave = tid >> 6;
  const int l16 = lane & 15, kg = lane >> 4;
  bf16_t* StT = (bf16_t*)smem;
  bf16_t* vnT = StT + 16 * 136;
  for (int i = tid; i < 16 * 136; i += 256) StT[i] = 0;
  f32x4 accS[2];
#pragma unroll
  for (int r = 0; r < 4; ++r) { accS[0][r] = 0.f; accS[1][r] = 0.f; }
  const int b = seq >> 2, h = seq & 3;
  bf16_t* Pout = (bf16_t*)(p.ws + OFF_P) + (size_t)(b * 4096) * 4096 + 1024 + h * 128 + slice * 16;
  const float* GL = (const float*)(p.ws + OFF_GLAST);
  const char* gbase = p.ws + OFF_R1 + (size_t)(seq * 64) * GDN_INT_BYTES;
  auto step = [&](const GdnFrag& cur, int c) {
    f32x4 accW, accQ;
#pragma unroll
    for (int r = 0; r < 4; ++r) { accW[r] = 0.f; accQ[r] = 0.f; }
#pragma unroll
    for (int s = 0; s < 4; ++s) {
      bf16x8 bS = *(const bf16x8*)(StT + l16 * 136 + 32 * s + 8 * kg);
      accW = MFMA16(cur.aW[s], bS, accW);
      accQ = MFMA16(cur.aQ[s], bS, accQ);
    }
    {
      const uint2 uu = cur.uu;
      float v0 = bflo(uu.x) - accW[0], v1 = bfhi(uu.x) - accW[1], v2 = bflo(uu.y) - accW[2], v3 = bfhi(uu.y) - accW[3];
      *(uint2*)(vnT + l16 * 72 + 16 * wave + 4 * kg) = pack4(v0, v1, v2, v3);
    }
    lds_barrier();
    bf16x8 bV[2];
#pragma unroll
    for (int s = 0; s < 2; ++s) bV[s] = *(const bf16x8*)(vnT + l16 * 72 + 32 * s + 8 * kg);
#pragma unroll
    for (int tI = 0; tI < 2; ++tI) {
#pragma unroll
      for (int r = 0; r < 4; ++r) accS[tI][r] *= cur.gl;
#pragma unroll
      for (int s = 0; s < 2; ++s) accS[tI] = MFMA16(cur.aD[tI][s], bV[s], accS[tI]);
      *(uint2*)(StT + l16 * 136 + 32 * wave + 16 * tI + 4 * kg) = pack4(accS[tI][0], accS[tI][1], accS[tI][2], accS[tI][3]);
    }
#pragma unroll
    for (int s = 0; s < 2; ++s) accQ = MFMA16(cur.aK[s], bV[s], accQ);
#pragma unroll
    for (int r = 0; r < 4; ++r) Pout[(size_t)(c * 64 + 16 * wave + 4 * kg + r) * 4096 + l16] = f2bf(accQ[r]);
    lds_barrier();
  };
  auto ld = [&](GdnFrag& f, int c) {
    const int cc = c < 64 ? c : 63;
    gdn_load(f, gbase + (size_t)cc * GDN_INT_BYTES, GL, seq * 64 + cc, slice, wave, l16, kg);
    __builtin_amdgcn_sched_barrier(0);
  };
  GdnFrag fa, fb;
  ld(fa, 0);
  __syncthreads();
  for (int c = 0; c < 64; c += 2) {
    ld(fb, c + 1);
    step(fa, c);
    __builtin_amdgcn_sched_barrier(0);
    ld(fa, c + 2);
    step(fb, c + 1);
    __builtin_amdgcn_sched_barrier(0);
  }
  __syncthreads();
}

struct MlFrag {
  bf16x8 aQ[4], bV[2], aP[2], aK[2][2];
  float4 rs4, fl4;
  float dec, kws;
};
DI void ml_load(MlFrag& f, const char* mi, const float* ms, int slice, int tid, int wave, int l16, int kg) {
  const bf16_t* q = (const bf16_t*)mi;
  const bf16_t* kwT = (const bf16_t*)(mi + 16384);
  const bf16_t* vT = (const bf16_t*)(mi + 32768);
  const bf16_t* pp = (const bf16_t*)(mi + 49152);
  const int ln = kg * 16 + l16;
#pragma unroll
  for (int s = 0; s < 4; ++s) f.aQ[s] = *(const bf16x8*)(q + (((wave * 4 + s) * 64 + ln) << 3));
#pragma unroll
  for (int s = 0; s < 2; ++s) {
    f.bV[s] = *(const bf16x8*)(vT + (((slice * 2 + s) * 64 + ln) << 3));
    f.aP[s] = *(const bf16x8*)(pp + (((wave * 2 + s) * 64 + ln) << 3));
#pragma unroll
    for (int tI = 0; tI < 2; ++tI) f.aK[tI][s] = *(const bf16x8*)(kwT + ((((2 * wave + tI) * 2 + s) * 64 + ln) << 3));
  }
  f.rs4 = *(const float4*)(ms + 16 * wave + 4 * kg);
  f.fl4 = *(const float4*)(ms + 64 + 16 * wave + 4 * kg);
  f.dec = ms[384];
  f.kws = ms[256 + (tid & 127)];
}

DI void mlstm_scan(const Params& p, int seq, int slice, char* smem) {
  const int tid = otid(), lane = tid & 63, wave = tid >> 6;
  const int l16 = lane & 15, kg = lane >> 4;
  bf16_t* CT = (bf16_t*)smem;
  float* s_n = (float*)(smem + 16 * 136 * 2);
  bf16_t* s_nb = (bf16_t*)(smem + 16 * 136 * 2 + 512);
  for (int i = tid; i < 16 * 136; i += 256) CT[i] = 0;
  if (tid < 128) { s_n[tid] = 0.f; s_nb[tid] = 0; }
  f32x4 accC[2];
#pragma unroll
  for (int r = 0; r < 4; ++r) { accC[0][r] = 0.f; accC[1][r] = 0.f; }
  const int b = seq >> 2, h = seq & 3;
  bf16_t* Pout = (bf16_t*)(p.ws + OFF_P) + (size_t)(b * 4096) * 4096 + 3072 + h * 128 + slice * 16;
  const char* mbase = (const char*)p.out + (size_t)(seq * 64) * ML_INT_BYTES;
  const float* msbase = (const float*)(p.ws + OFF_MSMALL) + (size_t)(seq * 64) * 512;
  auto step = [&](const MlFrag& cur, int c) {
    f32x4 accN, accD;
#pragma unroll
    for (int r = 0; r < 4; ++r) { accN[r] = 0.f; accD[r] = 0.f; }
#pragma unroll
    for (int s = 0; s < 4; ++s) {
      bf16x8 bC = *(const bf16x8*)(CT + l16 * 136 + 32 * s + 8 * kg);
      accN = MFMA16(cur.aQ[s], bC, accN);
      u32x4 nb = *(const u32x4*)(s_nb + 32 * s + 8 * kg);
      if (l16 != 0) { nb[0] = 0u; nb[1] = 0u; nb[2] = 0u; nb[3] = 0u; }
      accD = MFMA16(cur.aQ[s], __builtin_bit_cast(bf16x8, nb), accD);
      if (s == 1) __builtin_amdgcn_sched_barrier(0);
    }
#pragma unroll
    for (int s = 0; s < 2; ++s) accN = MFMA16(cur.aP[s], cur.bV[s], accN);
    const float rsv[4] = {cur.rs4.x, cur.rs4.y, cur.rs4.z, cur.rs4.w};
    const float flv[4] = {cur.fl4.x, cur.fl4.y, cur.fl4.z, cur.fl4.w};
#pragma unroll
    for (int r = 0; r < 4; ++r) {
      const float qnr = __shfl(accD[r], lane & 48);
      const int l = 16 * wave + 4 * kg + r;
      const float den = qnr + rsv[r];
      const float hv = accN[r] * __builtin_amdgcn_rcpf(fmaxf(fabsf(den), flv[r]));
      Pout[(size_t)(c * 64 + l) * 4096 + l16] = f2bf(hv);
    }
    lds_barrier();
    const float dec = cur.dec;
#pragma unroll
    for (int tI = 0; tI < 2; ++tI) {
#pragma unroll
      for (int r = 0; r < 4; ++r) accC[tI][r] *= dec;
#pragma unroll
      for (int s = 0; s < 2; ++s) accC[tI] = MFMA16(cur.aK[tI][s], cur.bV[s], accC[tI]);
      *(uint2*)(CT + l16 * 136 + 32 * wave + 16 * tI + 4 * kg) = pack4(accC[tI][0], accC[tI][1], accC[tI][2], accC[tI][3]);
    }
    if (tid < 128) {
      const float nn = dec * s_n[tid] + cur.kws;
      s_n[tid] = nn;
      s_nb[tid] = f2bf(nn);
    }
    lds_barrier();
  };
  auto ld = [&](MlFrag& f, int c) {
    const int cc = c < 64 ? c : 63;
    ml_load(f, mbase + (size_t)cc * ML_INT_BYTES, msbase + (size_t)cc * 512, slice, tid, wave, l16, kg);
    __builtin_amdgcn_sched_barrier(0);
  };
  MlFrag fa, fb;
  ld(fa, 0);
  __syncthreads();
  for (int c = 0; c < 64; c += 2) {
    ld(fb, c + 1);
    step(fa, c);
    __builtin_amdgcn_sched_barrier(0);
    ld(fa, c + 2);
    step(fb, c + 1);
    __builtin_amdgcn_sched_barrier(0);
  }
  __syncthreads();
}

DI void gate_phase(const Params& p) {
  const int tid_ = otid(); const int lane = tid_ & 63, wave = tid_ >> 6;
  const bf16_t* P = (const bf16_t*)(p.ws + OFF_P);
  bf16_t* MX = (bf16_t*)(p.ws + OFF_MX);
  const int hh = lane >> 3, part = lane & 7;
  const bool gdn = hh < 4;
  const int ocol = (gdn ? (1024 + hh * 128) : (3072 + (hh - 4) * 128)) + part * 16;
  const int gcol = (gdn ? (1536 + hh * 128) : (3584 + (hh - 4) * 128)) + part * 16;
  const float* wp = gdn ? (p.gdn_norm_w + part * 16) : (p.mlstm_norm_w + (hh - 4) * 128 + part * 16);
  float w[16];
#pragma unroll
  for (int j = 0; j < 4; ++j) {
    const float4 t4 = ((const float4*)wp)[j];
    w[4 * j] = t4.x; w[4 * j + 1] = t4.y; w[4 * j + 2] = t4.z; w[4 * j + 3] = t4.w;
  }
  for (int tok = blockIdx.x * 4 + wave; tok < T_TOK; tok += gridDim.x * 4) {
    const bf16_t* row = P + (size_t)tok * 4096;
    const uint4 oa = *(const uint4*)(row + ocol), ob = *(const uint4*)(row + ocol + 8);
    const uint4 ga = *(const uint4*)(row + gcol), gb = *(const uint4*)(row + gcol + 8);
    float o[16], g[16];
    unpack8(oa, o); unpack8(ob, o + 8);
    unpack8(ga, g); unpack8(gb, g + 8);
    float ss = 0.f;
#pragma unroll
    for (int k = 0; k < 16; ++k) ss += o[k] * o[k];
    ss += __shfl_xor(ss, 1);
    ss += __shfl_xor(ss, 2);
    ss += __shfl_xor(ss, 4);
    const float r = rsqrtf(ss * (1.f / 128.f) + 1e-6f);
    float y[16];
#pragma unroll
    for (int k = 0; k < 16; ++k) {
      const float sg = sigmoidf_(g[k]);
      const float a = gdn ? g[k] * sg : sg;
      y[k] = o[k] * r * w[k] * a;
    }
    bf16_t* dst = MX + (size_t)tok * 1024 + hh * 128 + part * 16;
    *(uint4*)dst = pack8(y);
    *(uint4*)(dst + 8) = pack8(y + 8);
  }
}

DI void attn_item(const Params& p, int item, char* smem) {
  const int tid = otid(), lane = tid & 63, wave = tid >> 6;
  const int l32 = lane & 31, half = lane >> 5;
  const int qt = item & 31, h = (item >> 5) & 3, b = item >> 7;
  const bf16_t* Qx = (const bf16_t*)(p.ws + OFF_QX);
  const bf16_t* Kb = (const bf16_t*)(p.ws + OFF_KB);
  const bf16_t* VT = (const bf16_t*)(p.ws + OFF_VT);
  bf16_t* AO = (bf16_t*)(p.ws + OFF_AO);
  bf16_t* Kc = (bf16_t*)smem;
  const int tokbase = b * 4096 + qt * 128 + 32 * wave;
  bf16x8 bq[16];
#pragma unroll
  for (int s = 0; s < 16; ++s) bq[s] = *(const bf16x8*)(Qx + (size_t)(tokbase + l32) * 1024 + h * 256 + 16 * s + 8 * half);
  f32x16 sacc[8];
#pragma unroll
  for (int jt = 0; jt < 8; ++jt)
#pragma unroll
    for (int r = 0; r < 16; ++r) sacc[jt][r] = 0.f;
#pragma unroll
  for (int c = 0; c < 4; ++c) {
    __syncthreads();
#pragma unroll
    for (int hf = 0; hf < 2; ++hf) {
      u32x4 st[4];
#pragma unroll
      for (int i = 0; i < 4; ++i) {
        const int row = (tid >> 5) + 8 * (4 * hf + i);
        st[i] = *(const u32x4*)(Kb + (size_t)(b * 256 + 64 * c + row) * 1024 + h * 256 + (tid & 31) * 8);
      }
#pragma unroll
      for (int i = 0; i < 4; ++i) {
        const int row = (tid >> 5) + 8 * (4 * hf + i);
        *(u32x4*)(Kc + row * 264 + (tid & 31) * 8) = st[i];
      }
    }
    __syncthreads();
#pragma unroll
    for (int jt2 = 0; jt2 < 2; ++jt2)
#pragma unroll
      for (int s = 0; s < 16; ++s) {
        const bf16x8 a = *(const bf16x8*)(Kc + (jt2 * 32 + l32) * 264 + 16 * s + 8 * half);
        sacc[2 * c + jt2] = MFMA32(a, bq[s], sacc[2 * c + jt2]);
      }
  }
  float mx = sacc[0][0];
#pragma unroll
  for (int jt = 0; jt < 8; ++jt)
#pragma unroll
    for (int r = 0; r < 16; ++r) mx = fmaxf(mx, sacc[jt][r]);
  mx = fmaxf(mx, __shfl_xor(mx, 32));
  float sum = 0.f;
  bf16x8 pf[8][2];
#pragma unroll
  for (int jt = 0; jt < 8; ++jt) {
#pragma unroll
    for (int ks = 0; ks < 2; ++ks) {
      float e[8];
#pragma unroll
      for (int k = 0; k < 8; ++k) {
        e[k] = __expf((sacc[jt][8 * ks + k] - mx) * 0.0625f);
        sum += e[k];
      }
      u32x4 pk;
      pk[0] = pk2(e[0], e[1]); pk[1] = pk2(e[2], e[3]); pk[2] = pk2(e[4], e[5]); pk[3] = pk2(e[6], e[7]);
      pf[jt][ks] = __builtin_bit_cast(bf16x8, pk);
    }
  }
  sum += __shfl_xor(sum, 32);
  const float inv = 1.f / sum;
  f32x16 oacc[8];
#pragma unroll
  for (int dt = 0; dt < 8; ++dt)
#pragma unroll
    for (int r = 0; r < 16; ++r) oacc[dt][r] = 0.f;
#pragma unroll
  for (int c = 0; c < 4; ++c) {
    __syncthreads();
#pragma unroll
    for (int hf = 0; hf < 2; ++hf) {
      u32x4 st[4];
#pragma unroll
      for (int i = 0; i < 4; ++i) {
        const int row = (tid >> 3) + 32 * (4 * hf + i);
        st[i] = *(const u32x4*)(VT + (size_t)((b * 4 + h) * 256 + row) * 256 + 64 * c + (tid & 7) * 8);
      }
#pragma unroll
      for (int i = 0; i < 4; ++i) {
        const int row = (tid >> 3) + 32 * (4 * hf + i);
        *(u32x4*)(Kc + row * 72 + (tid & 7) * 8) = st[i];
      }
    }
    __syncthreads();
#pragma unroll
    for (int jt2 = 0; jt2 < 2; ++jt2)
#pragma unroll
      for (int ks = 0; ks < 2; ++ks) {
        const bf16x8 bp = pf[2 * c + jt2][ks];
#pragma unroll
        for (int dt = 0; dt < 8; ++dt) {
          const bf16_t* vp = Kc + (32 * dt + l32) * 72 + 32 * jt2 + 16 * ks + 4 * half;
          const uint2 lo = *(const uint2*)vp, hi = *(const uint2*)(vp + 8);
          u32x4 av; av[0] = lo.x; av[1] = lo.y; av[2] = hi.x; av[3] = hi.y;
          oacc[dt] = MFMA32(__builtin_bit_cast(bf16x8, av), bp, oacc[dt]);
        }
      }
  }
  bf16_t* orow = AO + (size_t)(tokbase + l32) * 1024 + h * 256;
#pragma unroll
  for (int dt = 0; dt < 8; ++dt)
#pragma unroll
    for (int g4 = 0; g4 < 4; ++g4) {
      uint2 o;
      o.x = pk2(oacc[dt][4 * g4] * inv, oacc[dt][4 * g4 + 1] * inv);
      o.y = pk2(oacc[dt][4 * g4 + 2] * inv, oacc[dt][4 * g4 + 3] * inv);
      *(uint2*)(orow + 32 * dt + 8 * g4 + 4 * half) = o;
    }
  __syncthreads();
}

DI unsigned f2key(float f) {
  unsigned u = __float_as_uint(f);
  return (u & 0x80000000u) ? ~u : (u | 0x80000000u);
}
DI float key2f(unsigned k) {
  unsigned u = (k & 0x80000000u) ? (k & 0x7fffffffu) : ~k;
  return __uint_as_float(u);
}
DI void sort16_desc(unsigned* a) {
#pragma unroll
  for (int k = 2; k <= 16; k <<= 1)
#pragma unroll
    for (int j = k >> 1; j >= 1; j >>= 1)
#pragma unroll
      for (int i = 0; i < 16; ++i) {
        const int l = i ^ j;
        if (l > i) {
          const unsigned hi = max(a[i], a[l]), lo = min(a[i], a[l]);
          if ((i & k) == 0) { a[i] = hi; a[l] = lo; } else { a[i] = lo; a[l] = hi; }
        }
      }
}
DI void merge16_desc(unsigned* lst, const unsigned* oth) {
#pragma unroll
  for (int i = 0; i < 16; ++i) lst[i] = max(lst[i], oth[15 - i]);
#pragma unroll
  for (int st = 8; st >= 1; st >>= 1)
#pragma unroll
    for (int i = 0; i < 16; ++i)
      if ((i & st) == 0) {
        const unsigned hi = max(lst[i], lst[i + st]), lo = min(lst[i], lst[i + st]);
        lst[i] = hi;
        lst[i + st] = lo;
      }
}
DI void insert16(unsigned* lst, unsigned x) {
#pragma unroll
  for (int i = 0; i < 16; ++i) {
    unsigned hi = max(lst[i], x);
    x = min(lst[i], x);
    lst[i] = hi;
  }
}

DI void peer_route_item(const Params& p, int item, char* smem) {
  const int tid = otid(), lane = tid & 63, wave = tid >> 6;
  const int wm = wave >> 1, wn = wave & 1;
  const int mt = item >> 3, h = item & 7;
  const bf16_t* H3 = (const bf16_t*)(p.ws + OFF_H3);
  const bf16_t* PWqT = (const bf16_t*)(p.ws + OFF_PWQT);
  const bf16_t* SKb = (const bf16_t*)(p.ws + OFF_SKB);
  int* EID = (int*)(p.ws + OFF_EID);
  float* GATE = (float*)(p.ws + OFF_GATE);
  bf16_t* sA = (bf16_t*)smem;
  bf16_t* sB = (bf16_t*)(smem + 18432);
  bf16_t* Qs = (bf16_t*)(smem + 36864);
  unsigned* skey = (unsigned*)smem;
  unsigned char* itab = (unsigned char*)(smem + 71680);
  unsigned lst[2][16];
  const int token = tid >> 1, half = tid & 1;
#pragma unroll
  for (int pp = 0; pp < 2; ++pp) {
    const int m0 = mt * 128, n0 = (h * 2 + pp) * 128;
    gemm128(H3, 1024, PWqT, 1024, 1024, m0, n0, sA, sB,
            [&](int m, int n, float v) { Qs[(m - m0) * 136 + (n - n0)] = f2bf(v); });
    __syncthreads();
    f32x16 acc[2][2];
#pragma unroll
    for (int i = 0; i < 2; ++i)
#pragma unroll
      for (int j = 0; j < 2; ++j)
#pragma unroll
        for (int r = 0; r < 16; ++r) acc[i][j][r] = 0.f;
    const bf16_t* skp = SKb + (size_t)(h * 2 + pp) * 128 * 128;
#pragma unroll
    for (int s = 0; s < 8; ++s) {
      const int ko = s * 16 + (lane >> 5) * 8;
      bf16x8 a0 = *(const bf16x8*)(Qs + (wm * 64 + (lane & 31)) * 136 + ko);
      bf16x8 a1 = *(const bf16x8*)(Qs + (wm * 64 + 32 + (lane & 31)) * 136 + ko);
      bf16x8 b0 = *(const bf16x8*)(skp + (wn * 64 + (lane & 31)) * 128 + ko);
      bf16x8 b1 = *(const bf16x8*)(skp + (wn * 64 + 32 + (lane & 31)) * 128 + ko);
      acc[0][0] = MFMA32(a0, b0, acc[0][0]);
      acc[0][1] = MFMA32(a0, b1, acc[0][1]);
      acc[1][0] = MFMA32(a1, b0, acc[1][0]);
      acc[1][1] = MFMA32(a1, b1, acc[1][1]);
    }
    __syncthreads();
#pragma unroll
    for (int i = 0; i < 2; ++i)
#pragma unroll
      for (int j = 0; j < 2; ++j)
#pragma unroll
        for (int r = 0; r < 16; ++r) {
          const int row = wm * 64 + i * 32 + crow32(r, lane >> 5);
          const int colk = wn * 64 + j * 32 + (lane & 31);
          skey[row * 129 + colk] = (f2key(acc[i][j][r]) & ~127u) | (unsigned)(127 - colk);
        }
    __syncthreads();
    {
      const unsigned* kp = skey + token * 129 + half * 64;
#pragma unroll
      for (int i = 0; i < 16; ++i) lst[pp][i] = kp[i];
      sort16_desc(lst[pp]);
#pragma unroll
      for (int bt = 1; bt < 4; ++bt) {
        unsigned bb[16];
#pragma unroll
        for (int i = 0; i < 16; ++i) bb[i] = kp[bt * 16 + i];
        sort16_desc(bb);
        merge16_desc(lst[pp], bb);
      }
      unsigned oth[16];
#pragma unroll
      for (int i = 0; i < 16; ++i) oth[i] = __shfl_xor(lst[pp][i], 1);
      merge16_desc(lst[pp], oth);
    }
    __syncthreads();
  }
  if (half == 0) {
#pragma unroll
    for (int i = 0; i < 16; ++i) {
      itab[token * 32 + i] = (unsigned char)(127 - (lst[0][i] & 127u));
      itab[token * 32 + 16 + i] = (unsigned char)(127 - (lst[1][i] & 127u));
    }
  }
  float v0[16], v1[16];
#pragma unroll
  for (int i = 0; i < 16; ++i) {
    v0[i] = key2f(lst[0][i] & ~127u);
    v1[i] = key2f(lst[1][i] & ~127u);
  }
  unsigned best[16];
#pragma unroll
  for (int i = 0; i < 16; ++i) best[i] = (f2key(v0[i] + v1[0]) & ~255u) | (unsigned)(255 - i * 16);
#pragma unroll
  for (int i = 0; i < 16; ++i)
#pragma unroll
    for (int j = 1; j < 16; ++j)
      if ((i + 1) * (j + 1) <= 16) insert16(best, (f2key(v0[i] + v1[j]) & ~255u) | (unsigned)(255 - (i * 16 + j)));
  __syncthreads();
  float bv[16];
  float ssum = 0.f;
  const float vmax = key2f(best[0] & ~255u);
#pragma unroll
  for (int i = 0; i < 16; ++i) {
    bv[i] = __expf(key2f(best[i] & ~255u) - vmax);
    ssum += bv[i];
  }
  const float inv = 1.f / ssum;
  const size_t obase = ((size_t)(mt * 128 + token) * 8 + h) * 16;
  if (half == 0) {
#pragma unroll
    for (int i = 0; i < 8; ++i) {
      const int pay = 255 - (int)(best[i] & 255u);
      const int e = (int)itab[token * 32 + (pay >> 4)] * 128 + (int)itab[token * 32 + 16 + (pay & 15)];
      EID[obase + i] = e;
      GATE[obase + i] = bv[i] * inv;
    }
  } else {
#pragma unroll
    for (int i = 8; i < 16; ++i) {
      const int pay = 255 - (int)(best[i] & 255u);
      const int e = (int)itab[token * 32 + (pay >> 4)] * 128 + (int)itab[token * 32 + 16 + (pay & 15)];
      EID[obase + i] = e;
      GATE[obase + i] = bv[i] * inv;
    }
  }
  __syncthreads();
}

DI void convert_rows_fp8(const float* __restrict__ src, unsigned char* __restrict__ dst, float* __restrict__ scales, int nrows) {
  const int tid_ = otid();
  const int lane = tid_ & 63, wave = tid_ >> 6;
  for (int r = blockIdx.x * 4 + wave; r < nrows; r += gridDim.x * 4) {
    const float4* s = (const float4*)(src + (size_t)r * 1024 + 16 * lane);
    float4 v[4];
    float am = 0.f;
#pragma unroll
    for (int j = 0; j < 4; ++j) {
      v[j] = s[j];
      am = fmaxf(am, fmaxf(fmaxf(fabsf(v[j].x), fabsf(v[j].y)), fmaxf(fabsf(v[j].z), fabsf(v[j].w))));
    }
#pragma unroll
    for (int o = 32; o >= 1; o >>= 1) am = fmaxf(am, __shfl_xor(am, o));
    const float sc = (am > 0.f) ? am * (1.f / 384.f) : 1.f;
    const float inv = 1.f / sc;
    u32x4 o4;
#pragma unroll
    for (int j = 0; j < 4; ++j) {
      int pk = __builtin_amdgcn_cvt_pk_fp8_f32(v[j].x * inv, v[j].y * inv, 0, false);
      pk = __builtin_amdgcn_cvt_pk_fp8_f32(v[j].z * inv, v[j].w * inv, pk, true);
      o4[j] = (unsigned)pk;
    }
    *(u32x4*)(dst + (size_t)(lane >> 3) * (16384 * 128) + (size_t)r * 128 + 16 * (lane & 7)) = o4;
    if (lane == 0) scales[r] = sc;
  }
}
DI void unpack16_fp8(const u32x4& a, float* f) {
#pragma unroll
  for (int j = 0; j < 4; ++j) {
    f32x2 lo = __builtin_amdgcn_cvt_pk_f32_fp8((int)a[j], false);
    f32x2 hi = __builtin_amdgcn_cvt_pk_f32_fp8((int)a[j], true);
    f[4 * j] = lo[0]; f[4 * j + 1] = lo[1]; f[4 * j + 2] = hi[0]; f[4 * j + 3] = hi[1];
  }
}
struct PeerRows { u32x4 u[16]; uint4 xa, xb; };
DI void peer_load_e(int* e, const int* EID, int tok, int q) {
  const int4* ep = (const int4*)(EID + (size_t)tok * 128 + 16 * q);
#pragma unroll
  for (int j = 0; j < 4; ++j) { const int4 v = ep[j]; e[4 * j] = v.x; e[4 * j + 1] = v.y; e[4 * j + 2] = v.z; e[4 * j + 3] = v.w; }
}
DI void peer_u_phase(const Params& p) {
  const int tid_ = otid();
  const int lane = tid_ & 63, wave = tid_ >> 6;
  const int g = blockIdx.x & 7, rank = blockIdx.x >> 3, nrank = gridDim.x >> 3;
  if (rank >= nrank) return;
  const int q = lane >> 3, s = lane & 7;
  const bf16_t* H3 = (const bf16_t*)(p.ws + OFF_H3) + 128 * g + 16 * s;
  const unsigned char* Ub = (const unsigned char*)(p.ws + OFF_UB) + (size_t)g * (16384 * 128) + 16 * s;
  const int* EID = (const int*)(p.ws + OFF_EID);
  float* PART = (float*)(p.ws + OFF_PART) + (size_t)g * T_TOK * 128;
  const int first = rank * 4 + wave, stride = nrank * 4;
  const int n = (T_TOK - first + stride - 1) / stride;
  auto tokof = [&](int k) { return first + (k < n ? k : n - 1) * stride; };
  auto gather = [&](PeerRows& r, const int* e, int tok) {
#pragma unroll
    for (int i = 0; i < 16; ++i) r.u[i] = *(const u32x4*)(Ub + (size_t)e[i] * 128);
    r.xa = *(const uint4*)(H3 + (size_t)tok * 1024);
    r.xb = *(const uint4*)(H3 + (size_t)tok * 1024 + 8);
  };
  auto compute = [&](const PeerRows& r, int tok) {
    f32x2 x2[8];
    {
      float x[16];
      unpack8(r.xa, x);
      unpack8(r.xb, x + 8);
#pragma unroll
      for (int k = 0; k < 8; ++k) { x2[k][0] = x[2 * k]; x2[k][1] = x[2 * k + 1]; }
    }
    float pr[16];
#pragma unroll
    for (int i = 0; i < 16; ++i) {
      f32x2 aA = {0.f, 0.f}, aB = {0.f, 0.f};
#pragma unroll
      for (int j = 0; j < 4; ++j) {
        const f32x2 lo = __builtin_amdgcn_cvt_pk_f32_fp8((int)r.u[i][j], false);
        const f32x2 hi = __builtin_amdgcn_cvt_pk_f32_fp8((int)r.u[i][j], true);
        aA = __builtin_elementwise_fma(lo, x2[2 * j], aA);
        aB = __builtin_elementwise_fma(hi, x2[2 * j + 1], aB);
      }
      aA += aB;
      pr[i] = aA[0] + aA[1];
    }
    float r8[8], r4[4], r2[2];
#pragma unroll
    for (int k = 0; k < 8; ++k) {
      const float keep = (lane & 4) ? pr[k + 8] : pr[k], send = (lane & 4) ? pr[k] : pr[k + 8];
      r8[k] = keep + __shfl_xor(send, 4);
    }
#pragma unroll
    for (int k = 0; k < 4; ++k) {
      const float keep = (lane & 2) ? r8[k + 4] : r8[k], send = (lane & 2) ? r8[k] : r8[k + 4];
      r4[k] = keep + __shfl_xor(send, 2);
    }
#pragma unroll
    for (int k = 0; k < 2; ++k) {
      const float keep = (lane & 1) ? r4[k + 2] : r4[k], send = (lane & 1) ? r4[k] : r4[k + 2];
      r2[k] = keep + __shfl_xor(send, 1);
    }
    *(float2*)(PART + (size_t)tok * 128 + 2 * lane) = make_float2(r2[0], r2[1]);
  };
  int ea[16], eb[16];
  PeerRows ga, gb;
  peer_load_e(ea, EID, tokof(0), q);
  peer_load_e(eb, EID, tokof(1), q);
  gather(ga, ea, tokof(0));
  for (int k = 0; k < n; k += 2) {
    peer_load_e(ea, EID, tokof(k + 2), q);
    gather(gb, eb, tokof(k + 1));
    __builtin_amdgcn_sched_barrier(0);
    compute(ga, tokof(k));
    __builtin_amdgcn_sched_barrier(0);
    peer_load_e(eb, EID, tokof(k + 3), q);
    gather(ga, ea, tokof(k + 2));
    __builtin_amdgcn_sched_barrier(0);
    if (k + 1 < n) compute(gb, tokof(k + 1));
    __builtin_amdgcn_sched_barrier(0);
  }
}
DI void peer_w_phase(const Params& p) {
  const int tid_ = otid();
  const int lane = tid_ & 63, wave = tid_ >> 6;
  const float* PART = (const float*)(p.ws + OFF_PART);
  const float* Usc = (const float*)(p.ws + OFF_USC);
  const float* Vsc = (const float*)(p.ws + OFF_VSC);
  const int* EID = (const int*)(p.ws + OFF_EID);
  const float* GATE = (const float*)(p.ws + OFF_GATE);
  float* W = (float*)(p.ws + OFF_W);
  for (int tok = blockIdx.x * 4 + wave; tok < T_TOK; tok += gridDim.x * 4) {
    float t0 = 0.f, t1 = 0.f;
#pragma unroll
    for (int g = 0; g < 8; ++g) {
      const float2 v = *(const float2*)(PART + ((size_t)g * T_TOK + tok) * 128 + 2 * lane);
      t0 += v.x; t1 += v.y;
    }
    const int2 e = *(const int2*)(EID + (size_t)tok * 128 + 2 * lane);
    const float2 gt = *(const float2*)(GATE + (size_t)tok * 128 + 2 * lane);
    t0 *= Usc[e.x]; t1 *= Usc[e.y];
    const float a0 = 0.5f * t0 * (1.f + erff(t0 * 0.7071067811865476f));
    const float a1 = 0.5f * t1 * (1.f + erff(t1 * 0.7071067811865476f));
    *(float2*)(W + (size_t)tok * 128 + 2 * lane) = make_float2(gt.x * a0 * Vsc[e.x], gt.y * a1 * Vsc[e.y]);
  }
}
struct PeerVRows { u32x4 v[16]; float4 w[4]; };
DI void peer_v_phase(const Params& p) {
  const int tid_ = otid();
  const int lane = tid_ & 63, wave = tid_ >> 6;
  const int g = blockIdx.x & 7, rank = blockIdx.x >> 3, nrank = gridDim.x >> 3;
  if (rank >= nrank) return;
  const int q = lane >> 3, s = lane & 7;
  const unsigned char* Vb = (const unsigned char*)(p.ws + OFF_VB) + (size_t)g * (16384 * 128) + 16 * s;
  const int* EID = (const int*)(p.ws + OFF_EID);
  const float* W = (const float*)(p.ws + OFF_W);
  float* SSP = (float*)(p.ws + OFF_SSP) + (size_t)g * T_TOK;
  const int first = rank * 4 + wave, stride = nrank * 4;
  const int n = (T_TOK - first + stride - 1) / stride;
  auto tokof = [&](int k) { return first + (k < n ? k : n - 1) * stride; };
  auto gather = [&](PeerVRows& r, const int* e, int tok) {
#pragma unroll
    for (int i = 0; i < 16; ++i) r.v[i] = *(const u32x4*)(Vb + (size_t)e[i] * 128);
    const float4* wp = (const float4*)(W + (size_t)tok * 128 + 16 * q);
#pragma unroll
    for (int j = 0; j < 4; ++j) r.w[j] = wp[j];
  };
  auto compute = [&](const PeerVRows& r, int tok) {
    f32x2 o2[8];
#pragma unroll
    for (int k = 0; k < 8; ++k) { o2[k][0] = 0.f; o2[k][1] = 0.f; }
#pragma unroll
    for (int i = 0; i < 16; ++i) {
      const float wi = (i & 3) == 0 ? r.w[i >> 2].x : (i & 3) == 1 ? r.w[i >> 2].y : (i & 3) == 2 ? r.w[i >> 2].z : r.w[i >> 2].w;
      const f32x2 w2 = {wi, wi};
#pragma unroll
      for (int j = 0; j < 4; ++j) {
        const f32x2 lo = __builtin_amdgcn_cvt_pk_f32_fp8((int)r.v[i][j], false);
        const f32x2 hi = __builtin_amdgcn_cvt_pk_f32_fp8((int)r.v[i][j], true);
        o2[2 * j] = __builtin_elementwise_fma(lo, w2, o2[2 * j]);
        o2[2 * j + 1] = __builtin_elementwise_fma(hi, w2, o2[2 * j + 1]);
      }
    }
    float o[16];
#pragma unroll
    for (int k = 0; k < 8; ++k) { o[2 * k] = o2[k][0]; o[2 * k + 1] = o2[k][1]; }
    float r8[8], r4[4], r2[2];
#pragma unroll
    for (int k = 0; k < 8; ++k) {
      const float keep = (lane & 32) ? o[k + 8] : o[k], send = (lane & 32) ? o[k] : o[k + 8];
      r8[k] = keep + __shfl_xor(send, 32);
    }
#pragma unroll
    for (int k = 0; k < 4; ++k) {
      const float keep = (lane & 16) ? r8[k + 4] : r8[k], send = (lane & 16) ? r8[k] : r8[k + 4];
      r4[k] = keep + __shfl_xor(send, 16);
    }
#pragma unroll
    for (int k = 0; k < 2; ++k) {
      const float keep = (lane & 8) ? r4[k + 2] : r4[k], send = (lane & 8) ? r4[k] : r4[k + 2];
      r2[k] = keep + __shfl_xor(send, 8);
    }
    float* xr = p.out + (size_t)tok * 1024 + 128 * g + 16 * s + 2 * q;
    float2 y = *(const float2*)xr;
    y.x += r2[0]; y.y += r2[1];
    *(float2*)xr = y;
    const float ss = wave_sum(y.x * y.x + y.y * y.y);
    if (lane == 0) SSP[tok] = ss;
  };
  int ea[16], eb[16];
  PeerVRows ga, gb;
  peer_load_e(ea, EID, tokof(0), q);
  peer_load_e(eb, EID, tokof(1), q);
  gather(ga, ea, tokof(0));
  for (int k = 0; k < n; k += 2) {
    peer_load_e(ea, EID, tokof(k + 2), q);
    gather(gb, eb, tokof(k + 1));
    __builtin_amdgcn_sched_barrier(0);
    compute(ga, tokof(k));
    __builtin_amdgcn_sched_barrier(0);
    peer_load_e(eb, EID, tokof(k + 3), q);
    gather(ga, ea, tokof(k + 2));
    __builtin_amdgcn_sched_barrier(0);
    if (k + 1 < n) compute(gb, tokof(k + 1));
    __builtin_amdgcn_sched_barrier(0);
  }
}
DI void final_norm_phase(const Params& p) {
  const int tid_ = otid();
  const int lane = tid_ & 63, wave = tid_ >> 6;
  const float* SSP = (const float*)(p.ws + OFF_SSP);
  for (int tok = blockIdx.x * 4 + wave; tok < T_TOK; tok += gridDim.x * 4) {
    float ss = 0.f;
#pragma unroll
    for (int g = 0; g < 8; ++g) ss += SSP[(size_t)g * T_TOK + tok];
    const float rr = rsqrtf(ss * (1.f / 1024.f) + 1e-6f);
    float4* xr = (float4*)(p.out + (size_t)tok * 1024);
    const float4* fw = (const float4*)p.norm_final_w;
#pragma unroll
    for (int j = 0; j < 4; ++j) {
      float4 v = xr[lane + 64 * j];
      const float4 w4 = fw[lane + 64 * j];
      v.x *= rr * w4.x; v.y *= rr * w4.y; v.z *= rr * w4.z; v.w *= rr * w4.w;
      xr[lane + 64 * j] = v;
    }
  }
}

#ifndef LAST_PHASE
#define LAST_PHASE 99
#endif
__global__ void __launch_bounds__(256, 2) hymba_mega(Params p) {
  cg::grid_group grid = cg::this_grid();
  __shared__ __attribute__((aligned(16))) char smem[SMEM_BYTES];
  __shared__ uint4 xb_words;
  bf16_t* sA = (bf16_t*)smem;
  bf16_t* sB = (bf16_t*)(smem + 18432);
  char* ws = p.ws;
  if (ws == nullptr) grid.sync();
  if (threadIdx.x == 0) xb_words = make_uint4(0u, 0u, 0u, 0u);
  __syncthreads();
  const XcdBarrier xb = xcd_barrier_post((unsigned*)(ws + OFF_BAR), (volatile LAS unsigned*)&xb_words);

  transpose_all(p.w_in, 1024, 4112, (bf16_t*)(ws + OFF_WINT), 4112, 1, (float*)smem);
  transpose_all(p.w_out, 1024, 1024, (bf16_t*)(ws + OFF_WOUTT), 1024, 0, (float*)smem);
  transpose_all(p.xa_wq, 1024, 1024, (bf16_t*)(ws + OFF_WQT), 1024, 0, (float*)smem);
  transpose_all(p.xa_wkv, 1024, 2048, (bf16_t*)(ws + OFF_WKVT), 2048, 0, (float*)smem);
  transpose_all(p.xa_wo, 1024, 1024, (bf16_t*)(ws + OFF_WOT), 1024, 0, (float*)smem);
  transpose_all(p.peer_wq, 1024, 2048, (bf16_t*)(ws + OFF_PWQT), 2048, 0, (float*)smem);
  convert_f32_bf16(p.peer_sub_keys, (bf16_t*)(ws + OFF_SKB), 8 * 2 * 128 * 128 / 4);
  rmsnorm_rows(p.x, p.norm_mix_w, (bf16_t*)p.out, T_TOK);
  rmsnorm_rows(p.mem, p.norm_mem_w, (bf16_t*)(ws + OFF_MEMN), 1024);
  xcd_barrier(xb);

  {
    bf16_t* Pb = (bf16_t*)(ws + OFF_P);
    float* G = (float*)(ws + OFF_G);
    bf16_t* sB2 = (bf16_t*)(smem + 36864);
    for (int tile = blockIdx.x; tile < 2048 + 128; tile += gridDim.x) {
      if (tile < 2048) {
        const int mt = (tile & 7) * 8 + ((tile >> 6) & 7), nt = (tile >> 9) * 8 + ((tile >> 3) & 7);
        gemm256((const bf16_t*)p.out, 1024, (const bf16_t*)(ws + OFF_WINT), 1024, 1024, mt * 256, nt * 128, sA, sB2,
                [&](int m, int n, float v) { Pb[(size_t)m * 4096 + n] = f2bf(v); });
      } else {
        const int mt = tile - 2048;
        gemm128((const bf16_t*)p.out, 1024, (const bf16_t*)(ws + OFF_WINT), 1024, 1024, mt * 128, 4096, sA, sB,
                [&](int m, int n, float v) { if (n < 4112) G[(size_t)(n - 4096) * T_TOK + m] = v; });
      }
    }
  }
  xcd_barrier(xb);
  if (LAST_PHASE < 2) return;

  for (int it = blockIdx.x; it < 1024; it += gridDim.x) gdn_pre(p, it, smem);
  for (int it = blockIdx.x; it < 1024; it += gridDim.x) mlstm_pre(p, it, smem);
  xcd_barrier(xb);
  if (LAST_PHASE < 3) return;

  for (int it = blockIdx.x; it < 256 + 64; it += gridDim.x) {
    if (it < 128) gdn_scan(p, it & 15, it >> 4, smem);
    else if (it < 256) mlstm_scan(p, it & 15, (it - 128) >> 4, smem);
    else {
      bf16_t* Kb = (bf16_t*)(ws + OFF_KB);
      bf16_t* VT = (bf16_t*)(ws + OFF_VT);
      const int t2 = it - 256;
      const int mt = t2 >> 4, nt = t2 & 15;
      gemm256((const bf16_t*)(ws + OFF_MEMN), 1024, (const bf16_t*)(ws + OFF_WKVT), 1024, 1024, mt * 256, nt * 128, sA,
              (bf16_t*)(smem + 36864), [&](int m, int n, float v) {
                if (n < 1024) Kb[(size_t)m * 1024 + n] = f2bf(v);
                else {
                  const int d = (n - 1024) & 255, hh = (n - 1024) >> 8, bb = m >> 8, j = m & 255;
                  VT[(size_t)((bb * 4 + hh) * 256 + d) * 256 + j] = f2bf(v);
                }
              });
    }
  }
  xcd_barrier(xb);
  if (LAST_PHASE < 4) return;

  gate_phase(p);
  xcd_barrier(xb);

  {
    const float* x = p.x;
    float* out = p.out;
    for (int tile = blockIdx.x; tile < 64 * 8; tile += gridDim.x) {
      const int mt = (tile & 7) * 8 + (tile >> 6), nt = (tile >> 3) & 7;
      gemm256((const bf16_t*)(ws + OFF_MX), 1024, (const bf16_t*)(ws + OFF_WOUTT), 1024, 1024, mt * 256, nt * 128, sA, (bf16_t*)(smem + 36864),
              [&](int m, int n, float v) { out[(size_t)m * 1024 + n] = x[(size_t)m * 1024 + n] + v; });
    }
  }
  xcd_barrier(xb);
  if (LAST_PHASE < 6) return;

  rmsnorm_rows(p.out, p.norm_xa_w, (bf16_t*)(ws + OFF_H2), T_TOK);
  xcd_barrier(xb);

  const bool conv_first = blockIdx.x >= (gridDim.x >> 1);
  if (conv_first) convert_rows_fp8(p.peer_u, (unsigned char*)(ws + OFF_UB), (float*)(ws + OFF_USC), 16384);
  {
    bf16_t* Qx = (bf16_t*)(ws + OFF_QX);
    for (int tile = blockIdx.x; tile < 64 * 8; tile += gridDim.x) {
      const int mt = (tile & 7) * 8 + (tile >> 6), nt = (tile >> 3) & 7;
      gemm256((const bf16_t*)(ws + OFF_H2), 1024, (const bf16_t*)(ws + OFF_WQT), 1024, 1024, mt * 256, nt * 128, sA, (bf16_t*)(smem + 36864),
              [&](int m, int n, float v) { Qx[(size_t)m * 1024 + n] = f2bf(v); });
    }
  }
  if (!conv_first) convert_rows_fp8(p.peer_u, (unsigned char*)(ws + OFF_UB), (float*)(ws + OFF_USC), 16384);
  xcd_barrier(xb);

  if (conv_first) convert_rows_fp8(p.peer_v, (unsigned char*)(ws + OFF_VB), (float*)(ws + OFF_VSC), 16384);
  for (int it = blockIdx.x; it < 512; it += gridDim.x) {
    const int r = it >> 3;
    attn_item(p, ((it & 7) * 2 + (r >> 5)) * 32 + (r & 31), smem);
  }
  if (!conv_first) convert_rows_fp8(p.peer_v, (unsigned char*)(ws + OFF_VB), (float*)(ws + OFF_VSC), 16384);
  xcd_barrier(xb);

  {
    float* out = p.out;
    for (int tile = blockIdx.x; tile < 64 * 8; tile += gridDim.x) {
      const int mt = (tile & 7) * 8 + (tile >> 6), nt = (tile >> 3) & 7;
      gemm256((const bf16_t*)(ws + OFF_AO), 1024, (const bf16_t*)(ws + OFF_WOT), 1024, 1024, mt * 256, nt * 128, sA, (bf16_t*)(smem + 36864),
              [&](int m, int n, float v) { out[(size_t)m * 1024 + n] += v; });
    }
  }
  xcd_barrier(xb);
  if (LAST_PHASE < 10) return;

  rmsnorm_rows(p.out, p.norm_ffn_w, (bf16_t*)(ws + OFF_H3), T_TOK);
  xcd_barrier(xb);

  for (int it = blockIdx.x; it < 1024; it += gridDim.x) {
    const int mt = (it >> 9) * 64 + (it & 7) * 8 + ((it >> 6) & 7), hh = (it >> 3) & 7;
    peer_route_item(p, mt * 8 + hh, smem);
  }
  xcd_barrier(xb);

  peer_u_phase(p);
  xcd_barrier(xb);
  peer_w_phase(p);
  xcd_barrier(xb);
  peer_v_phase(p);
  xcd_barrier(xb);
  final_norm_phase(p);
}

extern "C" void kernel_launch(void* const* d_in, const int* in_sizes, int n_in, void* d_out, int out_size, void* d_ws,
                              size_t ws_size, hipStream_t stream) {
  static int grid_blocks = 0;
  if (!grid_blocks) {
    int dev = 0, cus = 0, per_cu = 0;
    hipGetDevice(&dev);
    hipDeviceGetAttribute(&cus, hipDeviceAttributeMultiprocessorCount, dev);
    hipOccupancyMaxActiveBlocksPerMultiprocessor(&per_cu, hymba_mega, 256, 0);
    if (per_cu > 2) per_cu = 2;
    grid_blocks = cus * per_cu;
  }
  if (ws_size < OFF_END) { fprintf(stderr, "workspace too small\n"); return; }
  Params p{};
  const float** pp = (const float**)&p;
  for (int i = 0; i < 24; ++i) pp[i] = (const float*)d_in[i];
  p.out = (float*)d_out;
  p.ws = (char*)d_ws;
  void* args[] = {&p};
  (void)hipMemsetAsync((char*)d_ws + OFF_BAR, 0, 16384, stream);
  hipError_t e = hipLaunchCooperativeKernel((void*)hymba_mega, dim3(grid_blocks), dim3(256), args, 0, stream);
  if (e != hipSuccess) fprintf(stderr, "cooperative launch failed: %s (grid %d)\n", hipGetErrorString(e), grid_blocks);
}
```
